# Optimizing an MI355X kernel written in HIP

```python
import math
import jax, jax.numpy as jnp
from jax import lax
import numpy as np

D_MODEL = 1024
BATCH = 8
SEQ = 4096
DEPTH = 2

N_MIXERS = 4
GROUP_WIDTH = D_MODEL // N_MIXERS
HEAD_DIM = 64
N_GROUP_HEADS = GROUP_WIDTH // HEAD_DIM
IN_WIDTH = 9 * GROUP_WIDTH
CONV_WIDTH = 31
POOL_WINDOWS = (2, 4, 8, 16)
POOL_GROUP = GROUP_WIDTH // len(POOL_WINDOWS)
DILATED_PATTERNS = ((128, 1), (512, 4), (2048, 16))
BLOCK = 128
DIFF_QK_DIM = HEAD_DIM // 2
ROPE_THETA = 500000.0
ROPE_FRACTION = 4
D_FF = 2816
N_EXPERTS = 8
TOP_K = 2
D_FF_EXPERT = 3584
N_DENSE = (DEPTH + 1) // 2
N_MOE = DEPTH // 2
NORM_EPS = 1e-5

kernel_name = "hymba_style_four_mixer_hybrid_moe"


def rms_norm(x, g):
    xf = x.astype(jnp.float32)
    y = xf * lax.rsqrt(jnp.mean(xf * xf, axis=-1, keepdims=True) + NORM_EPS)
    return (y * g.astype(jnp.float32)).astype(x.dtype)


def rope_tables(seq, rot_dim):
    pos = jnp.arange(seq, dtype=jnp.float32)
    inv = ROPE_THETA ** (-jnp.arange(0, rot_dim, 2, dtype=jnp.float32) / rot_dim)
    ang = pos[:, None] * inv[None, :]
    return jnp.cos(ang), jnp.sin(ang)


def apply_partial_rope(x, cos, sin):
    rot = 2 * cos.shape[-1]
    half = rot // 2
    xr = x[..., :rot].astype(jnp.float32)
    x1, x2 = xr[..., :half], xr[..., half:]
    c = cos[None, :, None, :]
    s = sin[None, :, None, :]
    out = jnp.concatenate([x1 * c - x2 * s, x2 * c + x1 * s], axis=-1).astype(x.dtype)
    return jnp.concatenate([out, x[..., rot:]], axis=-1)


def conformer_conv(u, dw_w, dw_b, ln_g, ln_b, pw_w):
    a, b = jnp.split(u, 2, axis=-1)
    z = a * jax.nn.sigmoid(b)
    z = lax.conv_general_dilated(
        z, dw_w[:, None, :], window_strides=(1,), padding=[(CONV_WIDTH - 1, 0)],
        dimension_numbers=("NWC", "WIO", "NWC"), feature_group_count=GROUP_WIDTH) + dw_b
    zf = z.astype(jnp.float32)
    mu = jnp.mean(zf, axis=-1, keepdims=True)
    var = jnp.mean(jnp.square(zf - mu), axis=-1, keepdims=True)
    zf = (zf - mu) * lax.rsqrt(var + NORM_EPS) * ln_g.astype(jnp.float32) + ln_b.astype(jnp.float32)
    z = jax.nn.silu(zf).astype(u.dtype)
    return z @ pw_w


def pool_mixer(u, pool_w, pool_scale):
    B, S, _ = u.shape
    uf = u.astype(jnp.float32)
    cs = jnp.cumsum(uf, axis=1)
    pos = jnp.arange(S)
    outs = []
    for g, w in enumerate(POOL_WINDOWS):
        sl = slice(g * POOL_GROUP, (g + 1) * POOL_GROUP)
        c = cs[..., sl]
        lag = jnp.pad(c[:, :-w], ((0, 0), (w, 0), (0, 0)))
        cnt = jnp.minimum(pos + 1, w).astype(jnp.float32)[None, :, None]
        outs.append((c - lag) / cnt - uf[..., sl])
    y = jnp.stack(outs, axis=2).astype(u.dtype)
    y = jnp.einsum("bsgp,gpq->bsgq", y, pool_w).reshape(B, S, GROUP_WIDTH)
    return y * pool_scale


def dilated_branch(q, k, v, dil, span):
    B, S, H, Dh = q.shape
    nb = -(-S // (dil * BLOCK))
    Sp = nb * BLOCK * dil

    def to_blocks(t):
        t = jnp.pad(t, ((0, 0), (0, Sp - S), (0, 0), (0, 0)))
        return t.reshape(B, nb, BLOCK, dil, H, Dh)

    def with_prev(t):
        prev = jnp.pad(t[:, :-1], ((0, 0), (1, 0), (0, 0), (0, 0), (0, 0), (0, 0)))
        return jnp.concatenate([prev, t], axis=2)

    qb = to_blocks(q)
    kk = with_prev(to_blocks(k))
    vv = with_prev(to_blocks(v))
    i = jnp.arange(BLOCK)[:, None]
    j = jnp.arange(2 * BLOCK)[None, :]
    dist = BLOCK + i - j
    band = (dist >= 0) & (dist <= span)
    valid = (jnp.arange(nb)[:, None, None] > 0) | (j >= BLOCK)[None]
    mask = band[None] & valid
    s = jnp.einsum("bnirhd,bnjrhd->bnrhij", qb, kk).astype(jnp.float32) * (Dh ** -0.5)
    s = jnp.where(mask[None, :, None, None], s, -jnp.inf)
    m = jnp.max(s, axis=-1, keepdims=True)
    p = jnp.exp(s - m)
    l = jnp.sum(p, axis=-1)
    o = jnp.einsum("bnrhij,bnjrhd->bnirhd", p.astype(v.dtype), vv).astype(jnp.float32)
    l_t = jnp.transpose(l, (0, 1, 4, 2, 3))
    lse = jnp.transpose(m[..., 0], (0, 1, 4, 2, 3)) + jnp.log(l_t)
    o = (o / l_t[..., None]).reshape(B, Sp, H, Dh)[:, :S]
    lse = lse.reshape(B, Sp, H)[:, :S]
    return o, lse


def dilated_attention(q, k, v):
    outs, lses = [], []
    for window, dil in DILATED_PATTERNS:
        o, lse = dilated_branch(q, k, v, dil, window // dil)
        outs.append(o)
        lses.append(lse)
    wts = jax.nn.softmax(jnp.stack(lses), axis=0)
    out = jnp.sum(wts[..., None] * jnp.stack(outs), axis=0)
    return out.astype(q.dtype)


def diff_attention(q, k, v, lam, lam_init, ln_g):
    B, S, H, Dv = v.shape
    nb = S // BLOCK
    q1, q2 = jnp.split(q, 2, axis=-1)
    k1, k2 = jnp.split(k, 2, axis=-1)
    scale = DIFF_QK_DIM ** -0.5
    q1b = jnp.moveaxis(q1.reshape(B, nb, BLOCK, H, DIFF_QK_DIM), 1, 0)
    q2b = jnp.moveaxis(q2.reshape(B, nb, BLOCK, H, DIFF_QK_DIM), 1, 0)
    kpos = jnp.arange(S)

    def one_block(args):
        n, qb1, qb2 = args
        qpos = n * BLOCK + jnp.arange(BLOCK)
        causal = kpos[None, :] <= qpos[:, None]

        def probs(qb, kf):
            s = jnp.einsum("bihd,bjhd->bhij", qb, kf).astype(jnp.float32) * scale
            return jax.nn.softmax(jnp.where(causal, s, -jnp.inf), axis=-1)

        a = probs(qb1, k1) - lam * probs(qb2, k2)
        return jnp.einsum("bhij,bjhd->bihd", a.astype(v.dtype), v)

    o = lax.map(one_block, (jnp.arange(nb), q1b, q2b))
    o = jnp.moveaxis(o, 0, 1).reshape(B, S, H, Dv)
    o = rms_norm(o, ln_g) * (1.0 - lam_init)
    return o.reshape(B, S, H * Dv)


def token_mixing(h, w_in, dw_w, dw_b, ln_g, ln_b, pw_w, pool_w, pool_scale,
                 lam_vecs, diff_g, w_out, lam_init, cos_c, sin_c, cos_d, sin_d):
    B, S, _ = h.shape
    G = GROUP_WIDTH
    u = h @ w_in
    y_a = conformer_conv(u[..., :2 * G], dw_w, dw_b, ln_g, ln_b, pw_w)
    y_b = pool_mixer(u[..., 2 * G:3 * G], pool_w, pool_scale)
    heads = lambda t: t.reshape(B, S, N_GROUP_HEADS, HEAD_DIM)
    qc = apply_partial_rope(heads(u[..., 3 * G:4 * G]), cos_c, sin_c)
    kc = apply_partial_rope(heads(u[..., 4 * G:5 * G]), cos_c, sin_c)
    vc = heads(u[..., 5 * G:6 * G])
    y_c = dilated_attention(qc, kc, vc).reshape(B, S, G)
    comp = lambda t: t.reshape(B, S, 2 * N_GROUP_HEADS, DIFF_QK_DIM)
    qd = apply_partial_rope(comp(u[..., 6 * G:7 * G]), cos_d, sin_d).reshape(B, S, N_GROUP_HEADS, HEAD_DIM)
    kd = apply_partial_rope(comp(u[..., 7 * G:8 * G]), cos_d, sin_d).reshape(B, S, N_GROUP_HEADS, HEAD_DIM)
    vd = heads(u[..., 8 * G:9 * G])
    lv = lam_vecs.astype(jnp.float32)
    lam = jnp.exp(jnp.sum(lv[0] * lv[1])) - jnp.exp(jnp.sum(lv[2] * lv[3])) + lam_init
    y_d = diff_attention(qd, kd, vd, lam, lam_init, diff_g)
    y = jnp.concatenate([y_a, y_b, y_c, y_d], axis=-1)
    return y @ w_out


def swiglu(h, wg, wu, wd):
    return (jax.nn.silu(h @ wg) * (h @ wu)) @ wd


def moe_swiglu(h, router, wg, wu, wd):
    B, S, D = h.shape
    t = h.reshape(-1, D)
    logits = (t @ router).astype(jnp.float32)
    top_vals, top_idx = lax.top_k(logits, TOP_K)
    gates = jax.nn.softmax(top_vals, axis=-1)
    combine = jnp.sum(jax.nn.one_hot(top_idx, N_EXPERTS, dtype=jnp.float32) * gates[..., None], axis=1)
    y = jnp.zeros(t.shape, jnp.float32)
    for e in range(N_EXPERTS):
        y = y + combine[:, e:e + 1] * swiglu(t, wg[e], wu[e], wd[e]).astype(jnp.float32)
    return y.astype(h.dtype).reshape(B, S, D)


def setup_inputs(seed: int = 0) -> dict:
    key = jax.random.key(seed)
    ks = jax.random.split(key, 24)
    f32 = jnp.float32
    nrm = lambda k, shape, scale: jax.random.normal(k, shape, f32) * scale
    G, L = GROUP_WIDTH, DEPTH
    return {
        "x": jax.random.normal(ks[0], (BATCH, SEQ, D_MODEL), f32),
        "norm1_g": 1.0 + nrm(ks[1], (L, D_MODEL), 0.02),
        "w_in": nrm(ks[2], (L, D_MODEL, IN_WIDTH), D_MODEL ** -0.5),
        "conv_dw_w": nrm(ks[3], (L, CONV_WIDTH, G), CONV_WIDTH ** -0.5),
        "conv_dw_b": nrm(ks[4], (L, G), 0.02),
        "conv_ln_g": 1.0 + nrm(ks[5], (L, G), 0.02),
        "conv_ln_b": nrm(ks[6], (L, G), 0.02),
        "conv_pw_w": nrm(ks[7], (L, G, G), G ** -0.5),
        "pool_w": nrm(ks[8], (L, len(POOL_WINDOWS), POOL_GROUP, POOL_GROUP), POOL_GROUP ** -0.5),
        "pool_scale": 1.0 + nrm(ks[9], (L, G), 0.1),
        "diff_lam": nrm(ks[10], (L, 4, DIFF_QK_DIM), 0.1),
        "diff_ln_g": 1.0 + nrm(ks[11], (L, HEAD_DIM), 0.02),
        "w_out": nrm(ks[12], (L, D_MODEL, D_MODEL), D_MODEL ** -0.5),
        "norm2_g": 1.0 + nrm(ks[13], (L, D_MODEL), 0.02),
        "ffn_w_gate": nrm(ks[14], (N_DENSE, D_MODEL, D_FF), D_MODEL ** -0.5),
        "ffn_w_up": nrm(ks[15], (N_DENSE, D_MODEL, D_FF), D_MODEL ** -0.5),
        "ffn_w_down": nrm(ks[16], (N_DENSE, D_FF, D_MODEL), D_FF ** -0.5),
        "moe_router": nrm(ks[17], (N_MOE, D_MODEL, N_EXPERTS), D_MODEL ** -0.5),
        "moe_w_gate": nrm(ks[18], (N_MOE, N_EXPERTS, D_MODEL, D_FF_EXPERT), D_MODEL ** -0.5),
        "moe_w_up": nrm(ks[19], (N_MOE, N_EXPERTS, D_MODEL, D_FF_EXPERT), D_MODEL ** -0.5),
        "moe_w_down": nrm(ks[20], (N_MOE, N_EXPERTS, D_FF_EXPERT, D_MODEL), D_FF_EXPERT ** -0.5),
        "final_g": 1.0 + nrm(ks[21], (D_MODEL,), 0.02),
    }


def reference(x, norm1_g, w_in, conv_dw_w, conv_dw_b, conv_ln_g, conv_ln_b, conv_pw_w,
              pool_w, pool_scale, diff_lam, diff_ln_g, w_out, norm2_g,
              ffn_w_gate, ffn_w_up, ffn_w_down, moe_router, moe_w_gate, moe_w_up, moe_w_down,
              final_g):
    S = x.shape[1]
    cos_c, sin_c = rope_tables(S, HEAD_DIM // ROPE_FRACTION)
    cos_d, sin_d = rope_tables(S, DIFF_QK_DIM // ROPE_FRACTION)
    for layer in range(DEPTH):
        lam_init = 0.8 - 0.6 * math.exp(-0.3 * layer)
        h = rms_norm(x, norm1_g[layer])
        x = x + token_mixing(h, w_in[layer], conv_dw_w[layer], conv_dw_b[layer], conv_ln_g[layer],
                             conv_ln_b[layer], conv_pw_w[layer], pool_w[layer], pool_scale[layer],
                             diff_lam[layer], diff_ln_g[layer], w_out[layer], lam_init,
                             cos_c, sin_c, cos_d, sin_d)
        h = rms_norm(x, norm2_g[layer])
        if layer % 2 == 0:
            i = layer // 2
            x = x + swiglu(h, ffn_w_gate[i], ffn_w_up[i], ffn_w_down[i])
        else:
            i = layer // 2
            x = x + moe_swiglu(h, moe_router[i], moe_w_gate[i], moe_w_up[i], moe_w_down[i])
    return rms_norm(x, final_g)
```

```cpp
#include <hip/hip_runtime.h>
#include <hip/hip_bf16.h>
#include <cstdio>
#include <cstdint>
#include <cmath>
namespace pg8 {
#define PG8_LAS __attribute__((address_space(3)))
typedef unsigned short bf16_t;
typedef short bf16x8 __attribute__((ext_vector_type(8)));
typedef float f32x4 __attribute__((ext_vector_type(4)));
typedef unsigned u32x4 __attribute__((ext_vector_type(4)));
typedef unsigned u32x2 __attribute__((ext_vector_type(2)));
constexpr int BM = 256, BK = 64, HALF = 128, HTB = HALF * BK * 2  , STAGE_BYTES = 8 * HTB, NXCD = 8, WGM = 8;

__host__ __device__ __forceinline__ int lds_byte(int r, int c) { const int st = (r >> 4) * 2 + (c >> 5), rr = r & 15, cc = c & 31, ob = rr * 64 + cc * 2; return st * 1024 + (ob ^ (((ob >> 9) & 1) << 5)); }
__host__ __device__ __forceinline__ void stage_rc(int b, int& R, int& C) { const int st = b / 1024, sb = b % 1024, swz = sb ^ (((sb >> 9) & 1) << 5); R = (st >> 1) * 16 + swz / 64; C = (st & 1) * 32 + (swz % 64) / 2; }
__host__ __device__ __forceinline__ int perm32(int rho) { const int n = rho >> 4, i = rho & 15; return 8 * (i >> 2) + 4 * n + (i & 3); }

struct Unit { int pm, pn; };
struct Gemm { const bf16_t* A; const bf16_t* Bt; int M, N, K; };

struct StaticOrder {
    int nM, nN, nwg, G, c;
    __host__ __device__ void init(int M, int N, int G_, int c_) { nM = M / BM; nN = N / BM; nwg = nM * nN; G = G_; c = c_; }
    __host__ __device__ bool next(int i, Unit& u) const {
        const long L = (long)i * G + c; if (L >= nwg) return false;
        int wgid = (int)L; { const int q = nwg / NXCD, r = nwg % NXCD, xcd = wgid % NXCD, off = wgid / NXCD; wgid = (xcd < r ? xcd * (q + 1) : r * (q + 1) + (xcd - r) * q) + off; }
        const int nig = WGM * nN, gid = wgid / nig, fm = gid * WGM, gsz = (nM - fm) < WGM ? (nM - fm) : WGM;
        u.pm = fm + ((wgid % nig) % gsz); u.pn = (wgid % nig) / gsz; return true;
    }
    __device__ __forceinline__ const char* a_ptr(const Gemm& g, const Unit& u) const { return (const char*)g.A + (size_t)u.pm * ((size_t)BM * g.K * 2); }
    __device__ __forceinline__ const char* b_ptr(const Gemm& g, const Unit& u) const { return (const char*)g.Bt + (size_t)u.pn * ((size_t)BM * g.K * 2); }
    __device__ __forceinline__ void a_ready(const Unit&) const {}
    __device__ __forceinline__ void done(const Unit&) const {}
};
struct MoeOrder : StaticOrder {
    int tile0, a_off; int ts1, ts2, ts3, ts4, ts5, ts6, ts7; size_t estride;
    __device__ __forceinline__ bool next(int i, Unit& u) const { if (!StaticOrder::next(i, u)) return false; u.pm += tile0; return true; }
    __device__ __forceinline__ int expert(int pm) const { return (pm >= ts1) + (pm >= ts2) + (pm >= ts3) + (pm >= ts4) + (pm >= ts5) + (pm >= ts6) + (pm >= ts7); }
    __device__ __forceinline__ const char* a_ptr(const Gemm& g, const Unit& u) const { return (const char*)g.A + (size_t)(u.pm - a_off) * ((size_t)BM * g.K * 2); }
    __device__ __forceinline__ const char* b_ptr(const Gemm& g, const Unit& u) const { return (const char*)g.Bt + (size_t)expert(u.pm) * estride + (size_t)u.pn * ((size_t)BM * g.K * 2); }
};

__device__ __forceinline__ unsigned cvt_pk_bf16(float lo, float hi) { unsigned r; asm volatile("v_cvt_pk_bf16_f32 %0, %1, %2" : "=v"(r) : "v"(lo), "v"(hi)); return r; }
__device__ __forceinline__ u32x4 pack8(const f32x4 v0, const f32x4 v1) { u32x4 w; w.x = cvt_pk_bf16(v0[0], v0[1]); w.y = cvt_pk_bf16(v0[2], v0[3]); w.z = cvt_pk_bf16(v1[0], v1[1]); w.w = cvt_pk_bf16(v1[2], v1[3]); return w; }
__device__ __forceinline__ float sigm(float b) { return __builtin_amdgcn_rcpf(1.0f + __builtin_amdgcn_exp2f(-1.4426950408889634f * b)); }
constexpr float RMS_EPS = 1e-5f;
constexpr float SCALE_C = 0.125f * 1.4426950408889634f;
constexpr float SCALE_D = 0.17677669529663687f * 1.4426950408889634f;

template <bool PARTS> __device__ __forceinline__ float rsum(const float* ss, int row) {
    if (!PARTS) return ss[row];
    const f32x4* p = (const f32x4*)(ss + (size_t)row * 16); const f32x4 a = p[0], b = p[1], c = p[2], d = p[3];
    return (((a[0] + a[1]) + (a[2] + a[3])) + ((b[0] + b[1]) + (b[2] + b[3]))) + (((c[0] + c[1]) + (c[2] + c[3])) + ((d[0] + d[1]) + (d[2] + d[3])));
}
template <bool PARTS> struct EpiIn {
    static constexpr bool PERM = true, AFTER_DRAIN = false;
    const float* ss; bf16_t* ub; bf16_t* qd; const float* ropeC; const float* ropeD; size_t bstride;
    __device__ __forceinline__ void operator()(const f32x4 (&acc)[2][2][4][2], const Unit& u, int wr, int wc, int fr, int fq) const {
        asm volatile("" : "+v"(fr), "+v"(fq));
        const int pn = u.pn, row0 = u.pm * BM + wr * 64 + fr, cl = wc * 32 + 8 * fq;
        if (pn < 2) {
            bf16_t* Z = ub + (size_t)pn * HALF + cl;
#pragma unroll
            for (int ai = 0; ai < 2; ++ai)
#pragma unroll
                for (int m = 0; m < 4; ++m) { const int row = row0 + ai * HALF + m * 16; const float rs = __builtin_amdgcn_rsqf(rsum<PARTS>(ss, row) * (1.0f / 1024.0f) + RMS_EPS);
                    f32x4 z0, z1;
#pragma unroll
                    for (int j = 0; j < 4; ++j) { z0[j] = acc[ai][0][m][0][j] * rs * sigm(acc[ai][1][m][0][j] * rs); z1[j] = acc[ai][0][m][1][j] * rs * sigm(acc[ai][1][m][1][j] * rs); }
                    *(u32x4*)(Z + (size_t)row * 256) = pack8(z0, z1); asm volatile("" ::: "memory"); }
        } else if (pn == 2 || pn == 5 || pn == 8) {
            bf16_t* O = ub + (size_t)(pn == 2 ? 1 : (pn == 5 ? 4 : 6)) * bstride + cl;
#pragma unroll
            for (int ai = 0; ai < 2; ++ai)
#pragma unroll
                for (int m = 0; m < 4; ++m) { const int row = row0 + ai * HALF + m * 16; const float rs = __builtin_amdgcn_rsqf(rsum<PARTS>(ss, row) * (1.0f / 1024.0f) + RMS_EPS);
#pragma unroll
                    for (int bj = 0; bj < 2; ++bj) *(u32x4*)(O + (size_t)row * 256 + bj * HALF) = pack8(acc[ai][bj][m][0] * rs, acc[ai][bj][m][1] * rs);
                    asm volatile("" ::: "memory"); }
        } else if (pn < 5) {
            bf16_t* O = ub + (size_t)(pn - 1) * bstride + cl; const float sc = (pn == 3) ? SCALE_C : 1.0f;
            const bool rotw = (wc & 1) == 0; const bool rotl = fq < 2;
#pragma unroll
            for (int ai = 0; ai < 2; ++ai)
#pragma unroll
                for (int m = 0; m < 4; ++m) { const int row = row0 + ai * HALF + m * 16; const float rs = __builtin_amdgcn_rsqf(rsum<PARTS>(ss, row) * (1.0f / 1024.0f) + RMS_EPS) ;
                    f32x4 cs = (f32x4){1.f, 1.f, 1.f, 1.f}, sn = (f32x4){0.f, 0.f, 0.f, 0.f};
                    if (rotw) { const float* tp = ropeC + (size_t)(row & 4095) * 16 + (fq & 1) * 8; const f32x4 c4 = *(const f32x4*)tp, s4 = *(const f32x4*)(tp + 4); if (rotl) { cs = c4; sn = s4; } }
#pragma unroll
                    for (int bj = 0; bj < 2; ++bj) { const f32x4 x1 = acc[ai][bj][m][0] * rs, x2 = acc[ai][bj][m][1] * rs;
                        *(u32x4*)(O + (size_t)row * 256 + bj * HALF) = pack8((x1 * cs - x2 * sn) * sc, (x2 * cs + x1 * sn) * sc); }
                    asm volatile("" ::: "memory"); }
        } else {
            const bool rotl = fq == 0;
#pragma unroll
            for (int ai = 0; ai < 2; ++ai)
#pragma unroll
                for (int m = 0; m < 4; ++m) { const int row = row0 + ai * HALF + m * 16; const float rs = __builtin_amdgcn_rsqf(rsum<PARTS>(ss, row) * (1.0f / 1024.0f) + RMS_EPS);
                    f32x4 cs = (f32x4){1.f, 1.f, 1.f, 1.f}, sn = (f32x4){0.f, 0.f, 0.f, 0.f};
                    { const float* tp = ropeD + (size_t)(row & 4095) * 8; const f32x4 c4 = *(const f32x4*)tp, s4 = *(const f32x4*)(tp + 4); if (rotl) { cs = c4; sn = s4; } }
#pragma unroll
                    for (int bj = 0; bj < 2; ++bj) { const f32x4 x1 = acc[ai][bj][m][0] * rs, x2 = acc[ai][bj][m][1] * rs;
                        const f32x4 o1 = x1 * cs - x2 * sn, o2 = x2 * cs + x1 * sn;
                        if (pn == 6) { const int comp = 4 * bj + wc, which = comp & 1; bf16_t* q = qd + (size_t)row * 512 + comp * 64 + 8 * fq;
                            *(u32x4*)(q + which * 32) = pack8(o1 * SCALE_D, o2 * SCALE_D); *(u32x4*)(q + (1 - which) * 32) = (u32x4){0u, 0u, 0u, 0u}; }
                        else *(u32x4*)(ub + 5 * bstride + (size_t)row * 256 + bj * HALF + cl) = pack8(o1, o2); }
                    asm volatile("" ::: "memory"); }
        }
    }
};
template <bool DO_SS> struct EpiRes {
    static constexpr bool PERM = false, AFTER_DRAIN = false;
    const float* xin; float* xout; bf16_t* xb; float* ss;
    __device__ __forceinline__ void operator()(const f32x4 (&acc)[2][2][4][2], const Unit& u, int wr, int wc, int fr, int fq) const {
        asm volatile("" : "+v"(fr), "+v"(fq));
        const int row0 = u.pm * BM + wr * 64 + fr, col0 = u.pn * BM + wc * 32 + 4 * fq;
#pragma unroll
        for (int ai = 0; ai < 2; ++ai)
#pragma unroll
            for (int m = 0; m < 4; ++m) { const int row = row0 + ai * HALF + m * 16; const size_t off = (size_t)row * 1024 + col0; float part = 0.f;
#pragma unroll
                for (int bj = 0; bj < 2; ++bj)
#pragma unroll
                    for (int n = 0; n < 2; ++n) { const size_t o = off + bj * HALF + n * 16; const f32x4 v = *(const f32x4*)(xin + o) + acc[ai][bj][m][n];
                        *(f32x4*)(xout + o) = v; u32x2 w; w.x = cvt_pk_bf16(v[0], v[1]); w.y = cvt_pk_bf16(v[2], v[3]); *(u32x2*)(xb + o) = w;
                        part += (v[0] * v[0] + v[1] * v[1]) + (v[2] * v[2] + v[3] * v[3]); }
                if (DO_SS) { part += __shfl_xor(part, 16); part += __shfl_xor(part, 32);
                    if (fq == 0) ss[(size_t)row * 16 + u.pn * 4 + wc] = part; }
                asm volatile("" ::: "memory"); }
    }
};
template <bool PARTS> struct EpiGlu {
    static constexpr bool PERM = true, AFTER_DRAIN = false;
    bf16_t* H; int ldh; const float* ss; int o_off;
    __device__ __forceinline__ void operator()(const f32x4 (&acc)[2][2][4][2], const Unit& u, int wr, int wc, int fr, int fq) const {
        asm volatile("" : "+v"(fr), "+v"(fq));
        const int row0 = u.pm * BM + wr * 64 + fr; bf16_t* O = H + (size_t)u.pn * HALF + wc * 32 + 8 * fq;
#pragma unroll
        for (int ai = 0; ai < 2; ++ai)
#pragma unroll
            for (int m = 0; m < 4; ++m) { const int row = row0 + ai * HALF + m * 16; const float rs = __builtin_amdgcn_rsqf(rsum<PARTS>(ss, row) * (1.0f / 1024.0f) + RMS_EPS);
                f32x4 z0, z1;
#pragma unroll
                for (int j = 0; j < 4; ++j) { const float g0 = acc[ai][0][m][0][j] * rs, g1 = acc[ai][0][m][1][j] * rs;
                    z0[j] = g0 * sigm(g0) * (acc[ai][1][m][0][j] * rs); z1[j] = g1 * sigm(g1) * (acc[ai][1][m][1][j] * rs); }
                *(u32x4*)(O + (size_t)(row - o_off * BM) * ldh) = pack8(z0, z1); asm volatile("" ::: "memory"); }
    }
};
struct EpiY {
    static constexpr bool PERM = true, AFTER_DRAIN = false;
    bf16_t* Y;
    __device__ __forceinline__ void operator()(const f32x4 (&acc)[2][2][4][2], const Unit& u, int wr, int wc, int fr, int fq) const {
        asm volatile("" : "+v"(fr), "+v"(fq));
        const int row0 = u.pm * BM + wr * 64 + fr; bf16_t* O = Y + (size_t)u.pn * BM + wc * 32 + 8 * fq;
#pragma unroll
        for (int ai = 0; ai < 2; ++ai)
#pragma unroll
            for (int m = 0; m < 4; ++m) { const int row = row0 + ai * HALF + m * 16;
#pragma unroll
                for (int bj = 0; bj < 2; ++bj) *(u32x4*)(O + (size_t)row * 1024 + bj * HALF) = pack8(acc[ai][bj][m][0], acc[ai][bj][m][1]); }
    }
};
template <class Epi, class Sched, bool ALIGN_EPI = false, bool SP2 = false>
__device__ __forceinline__ void gemm_phase(PG8_LAS unsigned char* lds, const Gemm g, const Sched& S, const Epi& E) {
    int tid_ = threadIdx.x; asm volatile("" : "+v"(tid_));
    const int tid = tid_, wid = __builtin_amdgcn_readfirstlane(tid >> 6), lane = tid & 63, wr = wid >> 2, wc = wid & 3, fr = lane & 15, fq = lane >> 4;
    const int K = g.K, nt = K / BK;
    unsigned voffA[2], voffB[2];
#pragma unroll
    for (int i = 0; i < 2; ++i) { int R, C; stage_rc(tid * 16 + i * 8192, R, C); const int Rb = Epi::PERM ? ((R & ~31) + perm32(R & 31)) : R;
        voffA[i] = (unsigned)(R * K + C) * 2u; voffB[i] = (unsigned)(Rb * K + C) * 2u; }
    const size_t kstep = (size_t)(BK * 2);
    const size_t hstep = (size_t)HALF * K * 2;
    const unsigned ldsw = (unsigned)wid * 1024u;
    const int aoff = lds_byte(wr * 64 + fr, fq * 8), boff = lds_byte(wc * 32 + fr, fq * 8);
#define PG8_SA(b, h) (((b) * 2 + (h)) * HTB)
#define PG8_SB(b, h) ((4 + (b) * 2 + (h)) * HTB)
#define PG8_STAGE(bufoff, gbase, voff) do { _Pragma("unroll") for (int _i = 0; _i < 2; ++_i) \
        __builtin_amdgcn_global_load_lds((const unsigned*)((const char*)(gbase) + (voff)[_i]), (PG8_LAS unsigned*)(lds + (bufoff) + ldsw + _i * 8192), 16, 0, 0); } while (0)
#define PG8_LDA(dst, b, h) do { _Pragma("unroll") for (int m = 0; m < 4; ++m) _Pragma("unroll") for (int k = 0; k < 2; ++k) dst[m][k] = *(const PG8_LAS bf16x8*)(lds + PG8_SA(b, h) + aoff + m * 2048 + k * 1024); } while (0)
#define PG8_LDB(dst, b, h) do { _Pragma("unroll") for (int n = 0; n < 2; ++n) _Pragma("unroll") for (int k = 0; k < 2; ++k) dst[n][k] = *(const PG8_LAS bf16x8*)(lds + PG8_SB(b, h) + boff + n * 2048 + k * 1024); } while (0)
#define PG8_MMA(ai, bj, At, Bt) do { __builtin_amdgcn_s_setprio(1); _Pragma("unroll") for (int m = 0; m < 4; ++m) _Pragma("unroll") for (int n = 0; n < 2; ++n) _Pragma("unroll") for (int k = 0; k < 2; ++k) \
        acc[ai][bj][m][n] = __builtin_amdgcn_mfma_f32_16x16x32_bf16(Bt[n][k], At[m][k], acc[ai][bj][m][n], 0, 0, 0); __builtin_amdgcn_s_setprio(0); } while (0)
#define PG8_WAIT_V(n) asm volatile("s_waitcnt vmcnt(" #n ")" ::: "memory")
#define PG8_WAIT_L(n) asm volatile("s_waitcnt lgkmcnt(" #n ")" ::: "memory")
#define PG8_BAR __builtin_amdgcn_s_barrier()
#define PG8_SCHED __builtin_amdgcn_sched_barrier(0)
    Unit cur, nxt; int ui = 0;
    if (!S.next(0, cur)) return;
    f32x4 acc[2][2][4][2];
#pragma unroll
    for (int a = 0; a < 2; ++a)
#pragma unroll
        for (int b = 0; b < 2; ++b)
#pragma unroll
            for (int m = 0; m < 4; ++m)
#pragma unroll
                for (int n = 0; n < 2; ++n) acc[a][b][m][n] = (f32x4){0.f, 0.f, 0.f, 0.f};
    bf16x8 At[4][2], B0[2][2], B1[2][2];
    const char* cA = S.a_ptr(g, cur); const char* cB = S.b_ptr(g, cur);
    S.a_ready(cur);
    if constexpr (SP2) {
        PG8_STAGE(PG8_SB(0, 0), cB, voffB); PG8_STAGE(PG8_SB(0, 1), cB + hstep, voffB); PG8_STAGE(PG8_SA(0, 0), cA, voffA); PG8_STAGE(PG8_SA(0, 1), cA + hstep, voffA);
        if (wr == 1) PG8_BAR;
        PG8_WAIT_V(2); PG8_BAR;
        PG8_STAGE(PG8_SB(1, 0), cB + kstep, voffB); PG8_STAGE(PG8_SA(1, 0), cA + kstep, voffA); PG8_STAGE(PG8_SB(1, 1), cB + hstep + kstep, voffB);
        PG8_WAIT_V(6); PG8_BAR;
    } else {
        PG8_STAGE(PG8_SB(0, 0), cB, voffB); PG8_STAGE(PG8_SA(0, 0), cA, voffA); PG8_STAGE(PG8_SB(0, 1), cB + hstep, voffB); PG8_STAGE(PG8_SA(0, 1), cA + hstep, voffA);
        if (wr == 1) PG8_BAR;
        PG8_WAIT_V(4); PG8_BAR;
        PG8_STAGE(PG8_SB(1, 0), cB + kstep, voffB); PG8_STAGE(PG8_SA(1, 0), cA + kstep, voffA); PG8_STAGE(PG8_SB(1, 1), cB + hstep + kstep, voffB);
        PG8_WAIT_V(6); PG8_BAR;
    }
    for (;;) {
        const bool has_next = S.next(ui + 1, nxt);
        const char* nA = has_next ? S.a_ptr(g, nxt) : cA; const char* nB = has_next ? S.b_ptr(g, nxt) : cB;
        for (int t = 0; t < nt; t += 2) {
            const bool last = (t == nt - 2);
            const char* a1 = cA + (size_t)(t + 1) * kstep;
            const char* a2 = last ? nA : cA + (size_t)(t + 2) * kstep; const char* b2 = last ? nB : cB + (size_t)(t + 2) * kstep;
            const char* a3 = a2 + kstep; const char* b3 = b2 + kstep;
            if (last && has_next) S.a_ready(nxt);
            if constexpr (SP2) {
            PG8_LDB(B0, 0, 0); PG8_LDB(B1, 0, 1); PG8_SCHED; PG8_LDA(At, 0, 0); PG8_STAGE(PG8_SA(1, 1), a1 + hstep, voffA);
            PG8_WAIT_V(8); PG8_WAIT_L(0); PG8_BAR; PG8_MMA(0, 0, At, B0); PG8_MMA(0, 1, At, B1); PG8_BAR; PG8_SCHED;
            PG8_LDA(At, 0, 1); PG8_STAGE(PG8_SB(0, 0), b2, voffB); PG8_STAGE(PG8_SB(0, 1), b2 + hstep, voffB); PG8_STAGE(PG8_SA(0, 0), a2, voffA);
            PG8_WAIT_V(8); PG8_WAIT_L(0); PG8_BAR; PG8_MMA(1, 0, At, B0); PG8_MMA(1, 1, At, B1); PG8_BAR; PG8_SCHED;
            PG8_LDB(B0, 1, 0); PG8_LDB(B1, 1, 1); PG8_SCHED; PG8_LDA(At, 1, 0); PG8_STAGE(PG8_SA(0, 1), a2 + hstep, voffA);
            PG8_WAIT_V(8); PG8_WAIT_L(0); PG8_BAR; PG8_MMA(0, 0, At, B0); PG8_MMA(0, 1, At, B1); PG8_BAR; PG8_SCHED;
            PG8_LDA(At, 1, 1); PG8_STAGE(PG8_SB(1, 0), b3, voffB); PG8_STAGE(PG8_SB(1, 1), b3 + hstep, voffB); PG8_STAGE(PG8_SA(1, 0), a3, voffA);
            PG8_WAIT_V(8); PG8_WAIT_L(0); PG8_BAR; PG8_MMA(1, 0, At, B0); PG8_MMA(1, 1, At, B1); PG8_BAR; PG8_SCHED;
            } else {
            PG8_LDB(B0, 0, 0); PG8_SCHED; PG8_LDA(At, 0, 0); PG8_STAGE(PG8_SA(1, 1), a1 + hstep, voffA);
            PG8_WAIT_L(8); PG8_BAR; PG8_WAIT_L(0); PG8_MMA(0, 0, At, B0); PG8_BAR; PG8_SCHED;
            PG8_LDB(B1, 0, 1); PG8_STAGE(PG8_SB(0, 0), b2, voffB);
            PG8_BAR; PG8_WAIT_L(0); PG8_MMA(0, 1, At, B1); PG8_BAR;
            PG8_LDA(At, 0, 1); PG8_STAGE(PG8_SA(0, 0), a2, voffA);
            PG8_BAR; PG8_WAIT_L(0); PG8_MMA(1, 0, At, B0); PG8_BAR; PG8_SCHED;
            PG8_STAGE(PG8_SB(0, 1), b2 + hstep, voffB);
            PG8_WAIT_V(6); PG8_BAR; PG8_MMA(1, 1, At, B1); PG8_BAR;
            PG8_LDB(B0, 1, 0); PG8_SCHED; PG8_LDA(At, 1, 0); PG8_STAGE(PG8_SA(0, 1), a2 + hstep, voffA);
            PG8_WAIT_L(8); PG8_BAR; PG8_WAIT_L(0); PG8_MMA(0, 0, At, B0); PG8_BAR; PG8_SCHED;
            PG8_LDB(B1, 1, 1); PG8_STAGE(PG8_SB(1, 0), b3, voffB);
            PG8_BAR; PG8_WAIT_L(0); PG8_MMA(0, 1, At, B1); PG8_BAR;
            PG8_LDA(At, 1, 1); PG8_STAGE(PG8_SA(1, 0), a3, voffA);
            PG8_BAR; PG8_WAIT_L(0); PG8_MMA(1, 0, At, B0); PG8_BAR; PG8_SCHED;
            PG8_STAGE(PG8_SB(1, 1), b3 + hstep, voffB);
            PG8_WAIT_V(6); PG8_BAR; PG8_MMA(1, 1, At, B1); PG8_BAR;
            }
        }
        if constexpr (ALIGN_EPI) { if (wr == 0) PG8_BAR; }
        if constexpr (!Epi::AFTER_DRAIN) { E(acc, cur, wr, wc, fr, fq); S.done(cur); }
        if (!has_next) break;
#pragma unroll
        for (int a = 0; a < 2; ++a)
#pragma unroll
            for (int b = 0; b < 2; ++b)
#pragma unroll
                for (int m = 0; m < 4; ++m)
#pragma unroll
                    for (int n = 0; n < 2; ++n) acc[a][b][m][n] = (f32x4){0.f, 0.f, 0.f, 0.f};
        cur = nxt; cA = nA; cB = nB; ++ui;
        if constexpr (ALIGN_EPI) { if (wr == 1) PG8_BAR; }
    }
    PG8_WAIT_V(0);
    if constexpr (!ALIGN_EPI) { if (wr == 0) PG8_BAR; }
    PG8_BAR;
    if constexpr (Epi::AFTER_DRAIN) { E.fused(acc, cur, wr, wc, fr, fq, lds, wid, lane); S.done(cur); }
#undef PG8_SA
#undef PG8_SB
#undef PG8_STAGE
#undef PG8_LDA
#undef PG8_LDB
#undef PG8_MMA
#undef PG8_WAIT_V
#undef PG8_WAIT_L
#undef PG8_BAR
#undef PG8_SCHED
}
}
namespace attn_body {
using bf16=__hip_bfloat16;
using bf16x8=__attribute__((ext_vector_type(8)))short;
using s16x4=__attribute__((ext_vector_type(4)))short;
using f32x16=__attribute__((ext_vector_type(16)))float;
using u32x4=__attribute__((ext_vector_type(4)))unsigned;
constexpr int SEQ=4096,D=64,QP=512,KP=256;
constexpr int NW=8,QBLK=32,QB=QBLK*NW,KVBLK=64,NQB=SEQ/QB;
constexpr int ATTN_UNIT_ROWS=QB;
__device__ __forceinline__ int crow(int r,int hi){return (r&3)+8*(r>>2)+4*hi;}
#define SBAR() __builtin_amdgcn_sched_barrier(0)
__device__ __forceinline__ void cmask(f32x16&p0,f32x16&p1,int jb,int qrel,int hi){
  const float NEG=-INFINITY; int kb=64*jb+4*hi;
  #pragma unroll
  for(int r=0;r<16;++r){int kv=kb+(r&3)+8*(r>>2); if(kv>qrel)p0[r]=NEG; if(kv+32>qrel)p1[r]=NEG;}
}

constexpr int NSLOT=3, SLOTB=8192;
constexpr int LDS_K=0, LDS_V=NSLOT*SLOTB, LDS_WS=2*NSLOT*SLOTB, LDS_OST=LDS_WS+NW*64*4, LDS_BYTES=LDS_OST+NW*4096;
constexpr float C2=0.125f*1.4426950408889634f;
__device__ __forceinline__ void glds16(const void*gsrc,unsigned lds_dst){unsigned keep;
  asm volatile("s_mov_b32 %0, m0\n\ts_mov_b32 m0, %2\n\ts_nop 0\n\tglobal_load_lds_dwordx4 %1, off\n\ts_mov_b32 m0, %0":"=&s"(keep):"v"(gsrc),"s"(lds_dst):"memory");}
__device__ __forceinline__ float max3f(float a,float b,float c){float r;asm("v_max3_f32 %0, %1, %2, %3":"=v"(r):"v"(a),"v"(b),"v"(c));return r;}
__device__ __forceinline__ float max2f(float a,float b){float r;asm("v_max_f32_e32 %0, %1, %2":"=v"(r):"v"(a),"v"(b));return r;}
__device__ __forceinline__ float fadd_s(float a,float b){float r;asm("v_add_f32_e32 %0, %1, %2":"=v"(r):"v"(a),"v"(b));return r;}
__device__ __forceinline__ float fsub_s(float a,float b){float r;asm("v_sub_f32_e32 %0, %1, %2":"=v"(r):"v"(a),"v"(b));return r;}
typedef float f32x2_t __attribute__((ext_vector_type(2))); typedef __bf16 bf16x2_t __attribute__((ext_vector_type(2)));
__device__ __forceinline__ unsigned cvtpk_s(float lo,float hi){f32x2_t v={lo,hi};bf16x2_t b=__builtin_convertvector(v,bf16x2_t);return __builtin_bit_cast(unsigned,b);}
#define WAIT_BAR(N) asm volatile("s_waitcnt vmcnt(" #N ") lgkmcnt(0)\n\ts_barrier":::"memory")

__device__ __forceinline__ void qkt(f32x16&p0,f32x16&p1,const char*Kslot,const bf16x8*qr,const f32x16&negm,int r32,int hi){
  const char*kb=Kslot+hi*1024+r32*16;
  #pragma unroll
  for(int d0=0;d0<4;++d0){
    const bf16x8 b0=*reinterpret_cast<const bf16x8*>(kb+d0*2048);
    const bf16x8 b1=*reinterpret_cast<const bf16x8*>(kb+d0*2048+512);
    if(d0==0){p0=__builtin_amdgcn_mfma_f32_32x32x16_bf16(b0,qr[0],negm,0,0,0);p1=__builtin_amdgcn_mfma_f32_32x32x16_bf16(b1,qr[0],negm,0,0,0);}
    else{p0=__builtin_amdgcn_mfma_f32_32x32x16_bf16(b0,qr[d0],p0,0,0,0);p1=__builtin_amdgcn_mfma_f32_32x32x16_bf16(b1,qr[d0],p1,0,0,0);}}
}
typedef __attribute__((address_space(3))) const char* lds_cptr;
typedef short v4i16_t __attribute__((ext_vector_type(4)));
__device__ __forceinline__ void kload8(bf16x8*kf,lds_cptr kp){
  kf[0]=*(const __attribute__((address_space(3))) bf16x8*)(kp);      kf[1]=*(const __attribute__((address_space(3))) bf16x8*)(kp+512);
  kf[2]=*(const __attribute__((address_space(3))) bf16x8*)(kp+2048); kf[3]=*(const __attribute__((address_space(3))) bf16x8*)(kp+2560);
  kf[4]=*(const __attribute__((address_space(3))) bf16x8*)(kp+4096); kf[5]=*(const __attribute__((address_space(3))) bf16x8*)(kp+4608);
  kf[6]=*(const __attribute__((address_space(3))) bf16x8*)(kp+6144); kf[7]=*(const __attribute__((address_space(3))) bf16x8*)(kp+6656);
}
__device__ __forceinline__ void kload2(bf16x8*kf,lds_cptr kp,int j){ kf[2*j]=*(const __attribute__((address_space(3))) bf16x8*)(kp+j*2048); kf[2*j+1]=*(const __attribute__((address_space(3))) bf16x8*)(kp+j*2048+512); }
__device__ __forceinline__ s16x4 vtr(lds_cptr p){ return __builtin_bit_cast(s16x4,__builtin_amdgcn_ds_read_tr16_b64_v4i16((__attribute__((address_space(3))) v4i16_t*)p)); }
__device__ __forceinline__ float rowmax(const f32x16&p0,const f32x16&p1){
  float a=max3f(p0[0],p0[1],p1[0]),b=max3f(p0[2],p0[3],p1[1]);a=max3f(a,p1[2],p1[3]);
  #pragma unroll
  for(int r=4;r<16;r+=4){a=max3f(a,p0[r],p0[r+1]);b=max3f(b,p0[r+2],p0[r+3]);a=max3f(a,p1[r],p1[r+1]);b=max3f(b,p1[r+2],p1[r+3]);}
  const float m=max2f(a,b);
  auto rr=__builtin_amdgcn_permlane32_swap(__float_as_uint(m),__float_as_uint(m),false,false);
  return max2f(__uint_as_float(rr[0]),__uint_as_float(rr[1]));
}
__device__ __forceinline__ void pv(f32x16*o,int vb,bf16x8 pa0,bf16x8 pa1,bf16x8 pa2,bf16x8 pa3){
  #pragma unroll
  for(int d0=0;d0<2;++d0){s16x4 lo[4],hi[4];
    #pragma unroll
    for(int ks=0;ks<4;++ks){
      asm volatile("ds_read_b64_tr_b16 %0,%1 offset:%c2":"=&v"(lo[ks]):"v"(vb),"i"(d0*4096+ks*1024):"memory");
      asm volatile("ds_read_b64_tr_b16 %0,%1 offset:%c2":"=&v"(hi[ks]):"v"(vb),"i"(d0*4096+ks*1024+512):"memory");}
    asm volatile("s_waitcnt lgkmcnt(0)":::"memory");SBAR();
    #define PK(k) (bf16x8){lo[k][0],lo[k][1],lo[k][2],lo[k][3],hi[k][0],hi[k][1],hi[k][2],hi[k][3]}
    o[d0]=__builtin_amdgcn_mfma_f32_32x32x16_bf16(pa0,PK(0),o[d0],0,0,0);
    o[d0]=__builtin_amdgcn_mfma_f32_32x32x16_bf16(pa1,PK(1),o[d0],0,0,0);
    o[d0]=__builtin_amdgcn_mfma_f32_32x32x16_bf16(pa2,PK(2),o[d0],0,0,0);
    o[d0]=__builtin_amdgcn_mfma_f32_32x32x16_bf16(pa3,PK(3),o[d0],0,0,0);
    #undef PK
  }
}

#ifndef ATTN_STORE16
#define ATTN_STORE16(p,v) (*(u32x4*)(p)=(v))
#endif
template<int THRL> __device__ __forceinline__ void attn_unit(int b,int h,int qb,const bf16*Q,const bf16*__restrict__ K,const bf16*__restrict__ V,bf16*O,char*shm){
  int tid_=threadIdx.x; asm volatile("":"+v"(tid_));
  const int tid=tid_,lane=tid&63,r32=lane&31,hi=lane>>5; const int wid=__builtin_amdgcn_readfirstlane(tid>>6);
  const long rowbase=(long)b*SEQ; const int q0=qb*QB;
  const bf16*Qw=Q+(rowbase+q0+wid*QBLK)*QP+h*D;
  const bf16*Kh=K+rowbase*KP+(h>>1)*D,*Vh=V+rowbase*KP+(h>>1)*D;
  const unsigned lds0=(unsigned)(uintptr_t)shm;
  float*wsf=(float*)(shm+LDS_WS)+wid*64;
  const bf16*ksrc=Kh+(long)lane*KP+wid*8;
  const bf16*vsrc=Vh+(long)(16*(wid&3)+(lane>>2))*KP+(wid>>2)*32+(lane&3)*8;
  const unsigned kdst=lds0+LDS_K+wid*1024, vdst=lds0+LDS_V+wid*1024;
  #define DMA_K(t,slot) glds16(ksrc+(long)(t)*KVBLK*KP,(unsigned)__builtin_amdgcn_readfirstlane(kdst+(slot)))
  #define DMA_V(t,slot) glds16(vsrc+(long)(t)*KVBLK*KP,(unsigned)__builtin_amdgcn_readfirstlane(vdst+(slot)))
  const int vb0=(int)(lds0+LDS_V)+((lane>>4)&1)*32+(lane&3)*8+(4*hi+((lane&15)>>2))*64;
  const char*Kbase=shm+LDS_K; bf16x8 kf[8];
  const lds_cptr shm3=(lds_cptr)shm; const lds_cptr kp0=shm3+LDS_K+hi*1024+r32*16; const lds_cptr vp0=shm3+LDS_V+((lane>>4)&1)*32+(lane&3)*8+(4*hi+((lane&15)>>2))*64;
  const int NT=(q0+QB)/KVBLK;
  DMA_K(0,0);DMA_V(0,0);DMA_K(1,SLOTB);
  bf16x8 qr[4];
  #pragma unroll
  for(int d0=0;d0<4;++d0)qr[d0]=*reinterpret_cast<const bf16x8*>(&Qw[(long)r32*QP+d0*16+hi*8]);
  float mhat=0.f,l_reg=0.f;f32x16 o[2];o[0]=f32x16{};o[1]=f32x16{};f32x16 negm=f32x16{};asm volatile("":"+v"(negm));
  const int qrel=wid*QBLK+r32;
  #define CMASK(P0,P1,t) do{int jb_=(t)-(NT-4); if(jb_>=0)cmask(P0,P1,jb_,qrel,hi);}while(0)
  bool resc=false;
  #define START(P0,P1) do{ const float rm=rowmax(P0,P1); resc=false; \
    { const float dl=rm; mhat=fadd_s(mhat,dl); \
      _Pragma("unroll") for(int r=0;r<16;++r){P0[r]=fsub_s(P0[r],dl);P1[r]=fsub_s(P1[r],dl);} \
      _Pragma("unroll") for(int r=0;r<16;++r)negm[r]=-mhat; asm volatile("":"+v"(negm)); } \
    _Pragma("unroll") for(int r=0;r<16;++r)P0[r]=__builtin_amdgcn_exp2f(P0[r]); }while(0)
  #define RESC() do{ if(resc){ asm volatile("s_waitcnt lgkmcnt(0)":::"memory"); \
      _Pragma("unroll") for(int d_=0;d_<2;++d_) _Pragma("unroll") for(int r=0;r<16;++r)o[d_][r]*=wsf[crow(r,hi)]; } }while(0)
  f32x16 pA0,pA1,pB0,pB1;
  int sl_prev=0,sl_cur=0,sl_next=SLOTB;
  #define ROT() do{sl_prev=sl_cur;sl_cur=sl_next;sl_next=(sl_next==(NSLOT-1)*SLOTB)?0:sl_next+SLOTB;}while(0)
  DMA_K(2,2*SLOTB);
  WAIT_BAR(3);
  qkt(pA0,pA1,Kbase,qr,negm,r32,hi);asm volatile("s_nop 15\n\ts_nop 7":"+v"(pA0),"+v"(pA1));CMASK(pA0,pA1,0);
  START(pA0,pA1);
  _Pragma("unroll") for(int r=0;r<16;++r)pA1[r]=__builtin_amdgcn_exp2f(pA1[r]);
  WAIT_BAR(0);
  DMA_K(3,0);DMA_V(1,SLOTB);
  ROT();
  kload8(kf,kp0+sl_cur);
  WAIT_BAR(2);
  s16x4 vlo[8],vhi[8]; u32x4 pw0,pw1,pw2,pw3;
  #define PKW(P,B) cvtpk_s(P[B],P[B+1])
  #define PAF(k) __builtin_bit_cast(bf16x8,pw##k)
  #define VFR(i) (bf16x8){vlo[i][0],vlo[i][1],vlo[i][2],vlo[i][3],vhi[i][0],vhi[i][1],vhi[i][2],vhi[i][3]}
  #define PIN(x) asm volatile("":"+v"(x))
  #define MX3(a,b,c) __builtin_fmaxf(__builtin_fmaxf((a),(b)),(c))
  #define GAPA(MF,A0,A1,A2,A3,W0,W1,PW) do{ MF; sacc+=A0; sacc+=A1; sacc+=A2; sacc+=A3; PIN(sacc); W0; W1; PIN(PW); SBAR(); }while(0)
  #define EX(v) __builtin_amdgcn_exp2f(v)
  #define GAPB(MF,X,B) do{ MF; X[B]=EX(X[B]); X[B+1]=EX(X[B+1]); X[B+2]=EX(X[B+2]); X[B+3]=EX(X[B+3]); PIN(X); SBAR(); }while(0)
  #define VRD(i) do{ vlo[i]=vtr(vp_+(((i)>>2)*4096+((i)&3)*1024)); vhi[i]=vtr(vp_+(((i)>>2)*4096+((i)&3)*1024+512)); }while(0)
  #define KRD(G,j) do{ if(G){ kload2(kf,kp0+sl_next,j); SBAR(); } }while(0)
  #define STEP(C0,C1,P0,P1,t,GK,GV,GL) do{ SBAR(); \
    const lds_cptr vp_=vp0+sl_prev; \
    VRD(0); SBAR(); float sacc=(P0[0]+P0[1]); \
    GAPA(C0=__builtin_amdgcn_mfma_f32_32x32x16_bf16(kf[0],qr[0],negm,0,0,0), P0[2],P0[3],P0[4],P0[5],     pw0[0]=PKW(P0,0), pw0[1]=PKW(P0,2), pw0); \
    VRD(4); SBAR(); GAPA(C1=__builtin_amdgcn_mfma_f32_32x32x16_bf16(kf[1],qr[0],negm,0,0,0), P0[6],P0[7],P0[8],P0[9],     pw0[2]=PKW(P0,4), pw0[3]=PKW(P0,6), pw0); \
    VRD(1); SBAR(); GAPA(C0=__builtin_amdgcn_mfma_f32_32x32x16_bf16(kf[2],qr[1],C0,0,0,0),   P0[10],P0[11],P0[12],P0[13], pw1[0]=PKW(P0,8), pw1[1]=PKW(P0,10), pw1); \
    VRD(5); SBAR(); GAPA(C1=__builtin_amdgcn_mfma_f32_32x32x16_bf16(kf[3],qr[1],C1,0,0,0),   P0[14],P0[15],P1[0],P1[1],   pw1[2]=PKW(P0,12),pw1[3]=PKW(P0,14), pw1); \
    VRD(2); SBAR(); GAPA(C0=__builtin_amdgcn_mfma_f32_32x32x16_bf16(kf[4],qr[2],C0,0,0,0),   P1[2],P1[3],P1[4],P1[5],     pw2[0]=PKW(P1,0), pw2[1]=PKW(P1,2), pw2); \
    VRD(6); SBAR(); GAPA(C1=__builtin_amdgcn_mfma_f32_32x32x16_bf16(kf[5],qr[2],C1,0,0,0),   P1[6],P1[7],P1[8],P1[9],     pw2[2]=PKW(P1,4), pw2[3]=PKW(P1,6), pw2); \
    VRD(3); SBAR(); GAPA(C0=__builtin_amdgcn_mfma_f32_32x32x16_bf16(kf[6],qr[3],C0,0,0,0),   P1[10],P1[11],P1[12],P1[13], pw3[0]=PKW(P1,8), pw3[1]=PKW(P1,10), pw3); \
    VRD(7); SBAR(); GAPA(C1=__builtin_amdgcn_mfma_f32_32x32x16_bf16(kf[7],qr[3],C1,0,0,0),   P1[14],P1[15],0.f,0.f,       pw3[2]=PKW(P1,12),pw3[3]=PKW(P1,14), pw3); \
    l_reg+=sacc; \
    if(GK){DMA_K((t)+3,sl_cur);} if(GV){DMA_V((t)+1,sl_next);} \
    CMASK(C0,C1,t); \
    { float a=MX3(C0[0],C0[1],C1[0]),b=MX3(C0[2],C0[3],C1[1]); a=MX3(a,C1[2],C1[3]); \
      _Pragma("unroll") for(int r=4;r<16;r+=4){a=MX3(a,C0[r],C0[r+1]);b=MX3(b,C0[r+2],C0[r+3]);a=MX3(a,C1[r],C1[r+1]);b=MX3(b,C1[r+2],C1[r+3]);} \
      float rm=__builtin_fmaxf(a,b); { auto rr=__builtin_amdgcn_permlane32_swap(__float_as_uint(rm),__float_as_uint(rm),false,false); rm=__builtin_fmaxf(__uint_as_float(rr[0]),__uint_as_float(rr[1])); } \
      resc=false; \
      if(__builtin_expect(__any(rm>(float)THRL),0)){ const float dl=__builtin_fmaxf(rm,0.f); mhat+=dl; \
        _Pragma("unroll") for(int r=0;r<16;++r){C0[r]-=dl;C1[r]-=dl;} \
        _Pragma("unroll") for(int r=0;r<16;++r)negm[r]=-mhat; asm volatile("":"+v"(negm)); \
        const float f=__builtin_amdgcn_exp2f(-dl); l_reg*=f; if(hi==0)wsf[r32]=f; resc=true; } } \
    SBAR(); \
    GAPB(o[0]=__builtin_amdgcn_mfma_f32_32x32x16_bf16(PAF(0),VFR(0),o[0],0,0,0), C0,0); \
    GAPB(o[1]=__builtin_amdgcn_mfma_f32_32x32x16_bf16(PAF(0),VFR(4),o[1],0,0,0), C0,4); \
    KRD(GL,0); GAPB(o[0]=__builtin_amdgcn_mfma_f32_32x32x16_bf16(PAF(1),VFR(1),o[0],0,0,0), C0,8); \
    KRD(GL,1); GAPB(o[1]=__builtin_amdgcn_mfma_f32_32x32x16_bf16(PAF(1),VFR(5),o[1],0,0,0), C0,12); \
    KRD(GL,2); GAPB(o[0]=__builtin_amdgcn_mfma_f32_32x32x16_bf16(PAF(2),VFR(2),o[0],0,0,0), C1,0); \
    KRD(GL,3); GAPB(o[1]=__builtin_amdgcn_mfma_f32_32x32x16_bf16(PAF(2),VFR(6),o[1],0,0,0), C1,4); \
    GAPB(o[0]=__builtin_amdgcn_mfma_f32_32x32x16_bf16(PAF(3),VFR(3),o[0],0,0,0), C1,8); \
    GAPB(o[1]=__builtin_amdgcn_mfma_f32_32x32x16_bf16(PAF(3),VFR(7),o[1],0,0,0), C1,12); \
    }while(0)
  int t=1;
  #undef CMASK
  #define CMASK(P0,P1,t) do{}while(0)
  for(;t+5<NT;t+=2){
    STEP(pB0,pB1,pA0,pA1,t,true,true,true);     WAIT_BAR(2); RESC(); ROT();
    STEP(pA0,pA1,pB0,pB1,t+1,true,true,true);   WAIT_BAR(2); RESC(); ROT();
  }
  #undef CMASK
  #define CMASK(P0,P1,t) do{int jb_=(t)-(NT-4); if(jb_>=0)cmask(P0,P1,jb_,qrel,hi);}while(0)
  #define ENDW(tt) do{ if((tt)+3<NT){WAIT_BAR(2);} else if((tt)+2<NT){WAIT_BAR(1);} else {WAIT_BAR(0);} }while(0)
  for(;t+1<NT;t+=2){
    STEP(pB0,pB1,pA0,pA1,t,(t+3<NT),(t+1<NT),(t+1<NT));       ENDW(t);   RESC(); ROT();
    STEP(pA0,pA1,pB0,pB1,t+1,(t+4<NT),(t+2<NT),(t+2<NT));     ENDW(t+1); RESC(); ROT();
  }
  STEP(pB0,pB1,pA0,pA1,NT-1,false,false,false); RESC();
  { float sacc=pB0[0]+pB0[1]; _Pragma("unroll") for(int r=2;r<16;++r)sacc+=pB0[r]; _Pragma("unroll") for(int r=0;r<16;++r)sacc+=pB1[r]; l_reg+=sacc;
    pw0=(u32x4){PKW(pB0,0),PKW(pB0,2),PKW(pB0,4),PKW(pB0,6)};pw1=(u32x4){PKW(pB0,8),PKW(pB0,10),PKW(pB0,12),PKW(pB0,14)};pw2=(u32x4){PKW(pB1,0),PKW(pB1,2),PKW(pB1,4),PKW(pB1,6)};pw3=(u32x4){PKW(pB1,8),PKW(pB1,10),PKW(pB1,12),PKW(pB1,14)};
    SBAR(); pv(o,vb0+sl_cur,PAF(0),PAF(1),PAF(2),PAF(3)); }
  #undef PKW
  #undef PAF
  #undef VFR
  #undef PIN
  #undef MX3
  #undef GAPA
  #undef GAPB
  #undef EX
  #undef VRD
  #undef KRD
  #undef STEP
  #undef ENDW
  {auto rr=__builtin_amdgcn_permlane32_swap(__float_as_uint(l_reg),__float_as_uint(l_reg),false,false);l_reg=__uint_as_float(rr[0])+__uint_as_float(rr[1]);}
  if(hi==0)wsf[32+r32]=l_reg;asm volatile("s_waitcnt lgkmcnt(0)":::"memory");
  float rli[16];
  #pragma unroll
  for(int r=0;r<16;++r)rli[r]=__builtin_amdgcn_rcpf(wsf[32+crow(r,hi)]);
  bf16*Ow=O+(rowbase+q0+wid*QBLK)*QP+h*D;
  { bf16*stg=(bf16*)(shm+LDS_OST)+wid*2048;
    #pragma unroll
    for(int r=0;r<16;++r){const int orow=crow(r,hi);
      #pragma unroll
      for(int d0=0;d0<2;++d0)stg[orow*64+d0*32+r32]=__float2bfloat16(o[d0][r]*rli[r]);}
    asm volatile("s_waitcnt lgkmcnt(0)":::"memory");
    #pragma unroll
    for(int i=0;i<4;++i){const int row=i*8+(lane>>3),ch=lane&7; const u32x4 v=*(const u32x4*)(stg+row*64+ch*8); ATTN_STORE16(Ow+(long)row*QP+ch*8,v);} }
  asm volatile("s_waitcnt lgkmcnt(0)\n\ts_barrier":::"memory");
  #undef DMA_K
  #undef DMA_V
  #undef CMASK
  #undef START
  #undef RESC
  #undef ROT
}
constexpr int ATTN_LDS_BYTES=LDS_BYTES;
#undef SBAR
#undef WAIT_BAR
}
#define GAS __attribute__((address_space(1)))
#define LAS __attribute__((address_space(3)))
typedef unsigned short bf16;
typedef unsigned v4u __attribute__((ext_vector_type(4)));
typedef float f32x4 __attribute__((ext_vector_type(4)));
typedef short bf16x8 __attribute__((ext_vector_type(8)));
typedef GAS unsigned gu32;
typedef GAS unsigned long long gu64;
#define RLX_AGENT __ATOMIC_RELAXED, __HIP_MEMORY_SCOPE_AGENT
#define LDS_WAIT() asm volatile("s_waitcnt lgkmcnt(0)" ::: "memory")
#define VM_WAIT() asm volatile("s_waitcnt vmcnt(0)" ::: "memory")
__device__ __forceinline__ unsigned long long rt() { return __builtin_amdgcn_s_memrealtime(); }
__device__ __forceinline__ unsigned f2bf(float f) { unsigned u = __builtin_bit_cast(unsigned, f); return (u + 0x7fffu + ((u >> 16) & 1u)) >> 16; }
__device__ __forceinline__ unsigned pk2(float lo, float hi) { return f2bf(lo) | (f2bf(hi) << 16); }

#define XB_TMO      128
#define XB_XCNT(j)  (256  + 64 * (j))
#define XB_XSUB(j)  (1280 + 64 * (j))
#define XB_XGEN(j)  (2304 + 64 * (j))
#define XB_TOP      3328
#define XB_TOPGEN   3392
#define XCD_BAR_WORDS 3456
#define XB_SPIN_CAP (1u << 18)

__device__ __forceinline__ unsigned xb_ld(unsigned* p)              { return __hip_atomic_load(p, __ATOMIC_RELAXED, __HIP_MEMORY_SCOPE_AGENT); }
__device__ __forceinline__ unsigned xb_add(unsigned* p, unsigned v) { return __hip_atomic_fetch_add(p, v, __ATOMIC_RELAXED, __HIP_MEMORY_SCOPE_AGENT); }
__device__ __forceinline__ unsigned xb_xcc_id() { return (unsigned)__builtin_amdgcn_s_getreg((3 << 11) | 20) & 0xFu; }
#define XB_SPIN(cond, bar) do { unsigned _sp = 0; while (cond) { __builtin_amdgcn_s_sleep(1); \
    if ((++_sp & 255u) == 0u) { if (xb_ld(&(bar)[XB_TMO])) break; if (_sp > XB_SPIN_CAP) { atomicAdd(&(bar)[XB_TMO], 1u); break; } } } } while (0)

struct XcdBarrier {
    unsigned* bar; unsigned x;
    volatile LAS unsigned* st;
};

__device__ __forceinline__ XcdBarrier xcd_barrier_post(unsigned* bar, volatile LAS unsigned* st) {
    XcdBarrier b; b.bar = bar; b.x = xb_xcc_id(); b.st = st;
    if (threadIdx.x == 0) (void)xb_add(&bar[XB_XCNT(b.x)], 1u);
    return b;
}
__device__ __forceinline__ void xcd_barrier_complete(unsigned* bar, unsigned x, unsigned& nloc, unsigned& nx) {
    const unsigned G = gridDim.x * gridDim.y * gridDim.z;
    unsigned sum, cnt, mine, sp = 0u;
    for (;;) {
        sum = 0u; cnt = 0u; mine = 0u;
#pragma unroll
        for (unsigned j = 0; j < 16; ++j) { const unsigned c = xb_ld(&bar[XB_XCNT(j)]); sum += c; cnt += (c > 0u) ? 1u : 0u; mine = (j == x) ? c : mine; }
        if (sum == G) break;
        __builtin_amdgcn_s_sleep(1);
        if ((++sp & 255u) == 0u) { if (xb_ld(&bar[XB_TMO])) break; if (sp > XB_SPIN_CAP) { atomicAdd(&bar[XB_TMO], 1u); break; } }
    }
    nloc = mine > 0u ? mine : 1u; nx = cnt > 0u ? cnt : 1u;
}

__device__ __forceinline__ void xcd_barrier(const XcdBarrier& b) {
    asm volatile("s_waitcnt vmcnt(0)" ::: "memory");
    __syncthreads();
    if (threadIdx.x == 0) {
        unsigned* bar = b.bar;
        __builtin_amdgcn_s_waitcnt(0);
        unsigned nloc = b.st[0], nx = b.st[1];
        if (nloc == 0u) { xcd_barrier_complete(bar, b.x, nloc, nx); b.st[0] = nloc; b.st[1] = nx; }
        const unsigned old = xb_add(&bar[XB_XSUB(b.x)], 1u);
        const unsigned gen = old / nloc;
        if (old + 1u == (gen + 1u) * nloc) {
            __builtin_amdgcn_fence(__ATOMIC_RELEASE, "agent");
            asm volatile("s_waitcnt vmcnt(0)" ::: "memory");
            const unsigned og = xb_add(&bar[XB_TOP], 1u);
            const unsigned tg = og / nx;
            if (og + 1u == (tg + 1u) * nx) xb_add(&bar[XB_TOPGEN], 1u);
            else XB_SPIN(xb_ld(&bar[XB_TOPGEN]) == tg, bar);
            __builtin_amdgcn_fence(__ATOMIC_ACQUIRE, "agent");
            xb_add(&bar[XB_XGEN(b.x)], 1u);
            asm volatile("s_waitcnt vmcnt(0)" ::: "memory");
        } else {
            XB_SPIN(xb_ld(&bar[XB_XGEN(b.x)]) == gen, bar);
            __builtin_amdgcn_fence(__ATOMIC_ACQUIRE, "agent");
            asm volatile("s_waitcnt vmcnt(0)" ::: "memory");
        }
    }
    __syncthreads();
}
constexpr int NWAVES = 8;
constexpr int NB = 8, SEQ = 4096, DM = 1024, T = NB * SEQ;
constexpr int GW = 256, NIN = 2304, DFF = 2816, NE = 8, DFE = 3584, CONVW = 31;
constexpr int MOE_CHUNK_TILES = 88, MOE_NCHUNK = 3, MOE_MAX_ROWS = MOE_CHUNK_TILES * MOE_NCHUNK * 256;
#ifndef MK_PER_PHASE
#define MK_PER_PHASE 1
#endif
constexpr int N_PHASES = 20;

constexpr size_t KiB = 1024, MiB = 1u << 20;
constexpr size_t WS_CTL = 0, CTL_ZERO_BYTES = 64 * KiB;
constexpr int CW_TMO = 0, CW_CODE = 1, CW_BAR = 4096, CW_ECNT = 8192;
constexpr size_t WS_TAB = 1 * MiB;
constexpr size_t WS_ROPEC = WS_TAB, WS_ROPED = WS_TAB + 256 * KiB, WS_MISC = WS_TAB + 384 * KiB, WS_SS0 = WS_TAB + 448 * KiB, WS_LSE = WS_TAB + 576 * KiB;
constexpr size_t WS_TOKE = WS_TAB + 2112 * KiB, WS_TOKG = WS_TAB + 2368 * KiB, WS_TOKP = WS_TAB + 2624 * KiB, WS_SSROW = WS_TAB + 2880 * KiB, WS_SST = WS_TAB + 3152 * KiB;
constexpr size_t WS_W = 4608 * KiB;
constexpr size_t SZ_WIN = (size_t)NIN * DM * 2, SZ_WOUT = (size_t)DM * DM * 2, SZ_W1 = (size_t)2 * DFF * DM * 2, SZ_W2 = (size_t)DM * DFF * 2, SZ_W1E = (size_t)2 * DFE * DM * 2, SZ_W2E = (size_t)DM * DFE * 2;
constexpr size_t WS_WIN = WS_W, WS_WOUT = WS_WIN + 2 * SZ_WIN, WS_W1 = WS_WOUT + 2 * SZ_WOUT, WS_W2 = WS_W1 + SZ_W1, WS_W1E = WS_W2 + SZ_W2, WS_W2E = WS_W1E + NE * SZ_W1E, WS_WEND = WS_W2E + NE * SZ_W2E;
constexpr size_t WS_ACT = 202 * MiB;
static_assert(WS_SSROW + (size_t)MOE_MAX_ROWS * 4 <= WS_SST && WS_SST + (size_t)T * 4 <= WS_W && WS_WEND <= WS_ACT, "d_ws map: tables / weights");
constexpr size_t SZ_TB = (size_t)T * 256 * 2;
constexpr size_t WS_XB = WS_ACT;
constexpr size_t WS_UB = WS_ACT + 64 * MiB;
constexpr size_t WS_QD = WS_UB + 7 * SZ_TB;
constexpr size_t WS_Y = WS_ACT + 208 * MiB;
constexpr size_t WS_OC = WS_ACT + 272 * MiB;
constexpr size_t WS_SSP = WS_OC;
constexpr size_t WS_HID = WS_ACT + 64 * MiB;
constexpr size_t WS_HS = WS_ACT + 188 * MiB;
constexpr size_t WS_HIDE = WS_ACT;
constexpr size_t WS_END = WS_ACT + 320 * MiB;
static_assert(WS_QD + (size_t)T * 512 * 2 == WS_Y && WS_Y + (size_t)T * 1024 * 2 == WS_OC && WS_OC + 3 * SZ_TB == WS_END, "d_ws map: activations");
static_assert(WS_HID + (size_t)T * DFF * 2 <= WS_END && WS_HS + (size_t)MOE_MAX_ROWS * 2048 == WS_END && WS_HIDE + (size_t)MOE_CHUNK_TILES * 256 * DFE * 2 <= WS_HS, "d_ws map: FFN overlays");

constexpr int RING_OFF = 0, RING_BYTES = 131072;
constexpr int LDSCTL_OFF = RING_BYTES, MISC_OFF = LDSCTL_OFF + 320;
constexpr int LDS_BYTES = 147456;
__device__ __forceinline__ float bf2f(unsigned short b) { return __uint_as_float((unsigned)b << 16); }
__device__ __forceinline__ float wave_sum(float v) {
#pragma unroll
    for (int o = 1; o < 64; o <<= 1) v += __shfl_xor(v, o);
    return v;
}
typedef float f32x16v __attribute__((ext_vector_type(16)));
typedef short s16x4v __attribute__((ext_vector_type(4)));
typedef unsigned v2u __attribute__((ext_vector_type(2)));

__device__ __forceinline__ const float* inp(const LAS unsigned char* lds, int i) {
    int i_ = i; asm volatile("" : "+s"(i_));
    const LAS unsigned* p = (const LAS unsigned*)(lds + LDSCTL_OFF) + 2 * i_;
    const unsigned lo = __builtin_amdgcn_readfirstlane(p[0]), hi = __builtin_amdgcn_readfirstlane(p[1]);
    return (const float*)(((unsigned long long)hi << 32) | lo);
}
__device__ __forceinline__ void tr_item(const float* W, int ldw, const float* gk, bf16* WT, int ldt, int k0, int sc0, int dr0, bool hperm, LAS float* scr, int lane) {
#pragma unroll 8
    for (int i = 0; i < 32; ++i) { const int kk = 2 * i + (lane >> 5); float v = W[(size_t)(k0 + kk) * ldw + sc0 + (lane & 31)]; if (gk) v *= gk[k0 + kk]; scr[kk * 33 + (lane & 31)] = v; }
    LDS_WAIT(); asm volatile("" ::: "memory");
    const int c = lane & 7;
#pragma unroll
    for (int j = 0; j < 4; ++j) { const int n = (lane >> 3) + 8 * j; int ns = n; if (hperm && n < 16) ns = ((n >> 2) & 1) * 8 + (n >> 3) * 4 + (n & 3);
        const LAS float* s = scr + (8 * c) * 33 + ns;
        v4u o; o.x = pk2(s[0 * 33], s[1 * 33]); o.y = pk2(s[2 * 33], s[3 * 33]); o.z = pk2(s[4 * 33], s[5 * 33]); o.w = pk2(s[6 * 33], s[7 * 33]);
        *(GAS v4u*)(WT + (size_t)(dr0 + n) * ldt + k0 + 8 * c) = o; }
    LDS_WAIT(); asm volatile("" ::: "memory");
}
__device__ __forceinline__ void tr_glu_item(const float* Wg, const float* Wu, int F, const float* gk, bf16* WT, int item, LAS float* scr, int lane) {
    const int nblk = 2 * F / 32, kb = item / nblk, nb = item % nblk, tile = nb >> 3, j = nb & 7;
    tr_item(j < 4 ? Wg : Wu, F, gk, WT, DM, 64 * kb, 128 * tile + 32 * (j & 3), 32 * nb, false, scr, lane);
}
#define IN_(i) inp(lds, (i))
__device__ __forceinline__ void p0_prologue(unsigned char* ws, LAS unsigned char* lds, int vcu, int G, int tid, int lane, int wave) {
    LAS float* scr = (LAS float*)(lds + RING_OFF + wave * 16384);
    const int gw = vcu * NWAVES + wave, NGW = G * NWAVES;
    const float* x = IN_(0);
    constexpr int I_IN = 16 * 72, I_OUT = 8 * 32, I_F1 = 16 * (2 * DFF / 32), I_F2 = (DFF / 64) * 32, I_E1 = 16 * (2 * DFE / 32), I_E2 = (DFE / 64) * 32;
    constexpr int NITEMS = 2 * I_IN + 2 * I_OUT + I_F1 + I_F2 + NE * I_E1 + NE * I_E2;
    for (int it = gw; it < NITEMS; it += NGW) {
        int r = it;
        if (r < 2 * I_IN) { const int l = r / I_IN; r -= l * I_IN; const int kb = r / 72, nb = r % 72, tile = nb >> 3, j = nb & 7;
            int sc0; if (tile == 0) sc0 = (j < 4) ? 32 * j : 256 + 32 * (j - 4); else if (tile == 1) sc0 = (j < 4) ? 128 + 32 * j : 384 + 32 * (j - 4); else sc0 = 256 * tile + 32 * j;
            tr_item(IN_(2) + (size_t)l * DM * NIN, NIN, IN_(1) + l * DM, (bf16*)(ws + WS_WIN + l * SZ_WIN), DM, 64 * kb, sc0, 32 * nb, (tile == 3 || tile == 4) && ((j & 1) == 0), scr, lane); continue; }
        r -= 2 * I_IN;
        if (r < 2 * I_OUT) { const int l = r / I_OUT; r -= l * I_OUT; const int kb = 8 + r / 32, nb = r % 32;
            tr_item(IN_(12) + (size_t)l * DM * DM, DM, nullptr, (bf16*)(ws + WS_WOUT + l * SZ_WOUT), DM, 64 * kb, 32 * nb, 32 * nb, false, scr, lane); continue; }
        r -= 2 * I_OUT;
        if (r < I_F1) { tr_glu_item(IN_(14), IN_(15), DFF, IN_(13), (bf16*)(ws + WS_W1), r, scr, lane); continue; }
        r -= I_F1;
        if (r < I_F2) { const int kb = r / 32, nb = r % 32; tr_item(IN_(16), DM, nullptr, (bf16*)(ws + WS_W2), DFF, 64 * kb, 32 * nb, 32 * nb, false, scr, lane); continue; }
        r -= I_F2;
        if (r < NE * I_E1) { const int e = r / I_E1; r -= e * I_E1;
            tr_glu_item(IN_(18) + (size_t)e * DM * DFE, IN_(19) + (size_t)e * DM * DFE, DFE, IN_(13) + DM, (bf16*)(ws + WS_W1E + e * SZ_W1E), r, scr, lane); continue; }
        r -= NE * I_E1;
        { const int e = r / I_E2; r -= e * I_E2; const int kb = r / 32, nb = r % 32;
            tr_item(IN_(20) + (size_t)e * DFE * DM, DM, nullptr, (bf16*)(ws + WS_W2E + e * SZ_W2E), DFE, 64 * kb, 32 * nb, 32 * nb, false, scr, lane); }
    }
    { bf16* xb = (bf16*)(ws + WS_XB); float* ss0 = (float*)(ws + WS_SS0);
      for (int m = gw; m < T; m += NGW) { const GAS f32x4* xr = (const GAS f32x4*)(x + (size_t)m * DM) + lane; GAS v2u* o8 = (GAS v2u*)(xb + (size_t)m * DM) + lane; float s = 0.f;
#pragma unroll
          for (int j = 0; j < 4; ++j) { const f32x4 v = xr[64 * j]; s += (v.x * v.x + v.y * v.y) + (v.z * v.z + v.w * v.w); v2u w; w.x = pk2(v.x, v.y); w.y = pk2(v.z, v.w); o8[64 * j] = w; }
          s = wave_sum(s); if (lane == 0) ss0[m] = s; } }
    { const int gt = vcu * (NWAVES * 64) + tid, NGT = G * NWAVES * 64;
      for (int it = gt; it < 2 * 512 * 256; it += NGT) { const int l = it >> 17, k = (it >> 8) & 511, n4 = it & 255;
          const float* wo = IN_(12) + (size_t)l * DM * DM; f32x4 a = (f32x4){0.f, 0.f, 0.f, 0.f};
          if (k < 256) { const float* pw = IN_(7) + (size_t)l * GW * GW + (size_t)k * GW;
              for (int j = 0; j < 256; ++j) a += pw[j] * *(const f32x4*)(wo + (size_t)j * DM + 4 * n4); }
          else { const int g = (k - 256) >> 6, p = (k - 256) & 63; const float* pw = IN_(8) + (size_t)l * 4 * 64 * 64 + (size_t)(g * 64 + p) * 64; const float* sc = IN_(9) + l * GW + 64 * g;
              for (int q = 0; q < 64; ++q) a += (pw[q] * sc[q]) * *(const f32x4*)(wo + (size_t)(256 + 64 * g + q) * DM + 4 * n4); }
          bf16* wt = (bf16*)(ws + WS_WOUT + l * SZ_WOUT) + (size_t)(4 * n4) * DM + k;
          wt[0] = (bf16)f2bf(a.x); wt[DM] = (bf16)f2bf(a.y); wt[2 * DM] = (bf16)f2bf(a.z); wt[3 * DM] = (bf16)f2bf(a.w); }
      float* rc = (float*)(ws + WS_ROPEC); float* rd = (float*)(ws + WS_ROPED);
      for (int it = gt; it < SEQ * 12; it += NGT) { const int pos = it / 12, i = it % 12;
          if (i < 8) { const float inv = powf(500000.0f, -(float)(2 * i) / 16.0f); const float ang = (float)pos * inv; rc[pos * 16 + (i >> 2) * 8 + (i & 3)] = cosf(ang); rc[pos * 16 + (i >> 2) * 8 + 4 + (i & 3)] = sinf(ang); }
          else { const int i2 = i - 8; const float inv = powf(500000.0f, -(float)(2 * i2) / 8.0f); const float ang = (float)pos * inv; rd[pos * 8 + i2] = cosf(ang); rd[pos * 8 + 4 + i2] = sinf(ang); } }
      if (gt < 2) { const int l = gt; const float* lv = IN_(10) + l * 128; float s01 = 0.f, s23 = 0.f; for (int j = 0; j < 32; ++j) { s01 += lv[j] * lv[32 + j]; s23 += lv[64 + j] * lv[96 + j]; }
          const float li = 0.8f - 0.6f * expf(-0.3f * (float)l); float* mi = (float*)(ws + WS_MISC); mi[2 * l] = expf(s01) - expf(s23) + li; mi[2 * l + 1] = 1.0f - li; }
    }
}
constexpr int CK_PITCH = 144, CV_OFF = 384 * CK_PITCH, CV_HALF = 384 * 64, CS_OFF = CV_OFF + 2 * CV_HALF;
static_assert(CS_OFF + NWAVES * 128 <= RING_BYTES, "dilated-attention LDS");
__device__ __forceinline__ s16x4v vtr16(const LAS unsigned char* p) { return __builtin_bit_cast(s16x4v, __builtin_amdgcn_ds_read_tr16_b64_v4i16((LAS s16x4v*)p)); }
__device__ __forceinline__ int crow16(int r, int hi) { return (r & 3) + 8 * (r >> 2) + 4 * hi; }
__device__ __forceinline__ void dil_unit(int uc, const bf16* QC, const bf16* KC, const bf16* VC, bf16* OCb, float* LSEb, LAS unsigned char* lds, int tid, int lane, int wid) {
    const int br = uc >> 9, rem = uc & 511, bh = rem >> 4, blk = rem & 15, b = bh >> 2, h = bh & 3;
    const int sh = 2 * br, dil = 1 << sh, r = blk & (dil - 1), m0 = (blk >> sh) << 8;
    const size_t tok0 = (size_t)b * SEQ;
    bf16* OC = OCb + (size_t)br * T * 256; float* LSE = LSEb + (size_t)br * T * 4;
    for (int i = tid; i < 3072; i += NWAVES * 64) {
        const int j = i >> 3, ch = i & 7, m = m0 - 128 + j;
        v4u kv = (v4u){0u, 0u, 0u, 0u}, vv = (v4u){0u, 0u, 0u, 0u};
        if (m >= 0) { const size_t off = (tok0 + ((size_t)m << sh) + r) * 256 + h * 64 + ch * 8; kv = *(const GAS v4u*)(KC + off); vv = *(const GAS v4u*)(VC + off); }
        *(LAS v4u*)(lds + j * CK_PITCH + ch * 16) = kv;
        *(LAS v4u*)(lds + CV_OFF + (ch >> 2) * CV_HALF + j * 64 + (ch & 3) * 16) = vv;
    }
    __syncthreads();
    const int r32 = lane & 31, hi = lane >> 5;
    const size_t qtok = tok0 + ((size_t)(m0 + 32 * wid + r32) << sh) + r;
    bf16x8 qr[4];
#pragma unroll
    for (int d0 = 0; d0 < 4; ++d0) qr[d0] = *(const GAS bf16x8*)(QC + qtok * 256 + h * 64 + d0 * 16 + hi * 8);
    f32x16v S[5];
    const LAS unsigned char* kbase = lds + (32 * wid + r32) * CK_PITCH + hi * 16;
#pragma unroll
    for (int jb = 0; jb < 5; ++jb) { f32x16v a = {};
#pragma unroll
        for (int d0 = 0; d0 < 4; ++d0) { const bf16x8 kf = *(const LAS bf16x8*)(kbase + jb * 32 * CK_PITCH + d0 * 32); a = __builtin_amdgcn_mfma_f32_32x32x16_bf16(kf, qr[d0], a, 0, 0, 0); }
        S[jb] = a; }
    const int kmin = (m0 == 0) ? (128 - 32 * wid) : 0;
    { const int lo0 = r32 > kmin ? r32 : kmin;
#pragma unroll
      for (int rg = 0; rg < 16; ++rg) { const int c = crow16(rg, hi); if (c < lo0) S[0][rg] = -INFINITY; if (c > r32) S[4][rg] = -INFINITY; }
      if (kmin > 32) {
#pragma unroll
          for (int jb = 1; jb < 4; ++jb)
#pragma unroll
              for (int rg = 0; rg < 16; ++rg) { if (32 * jb + crow16(rg, hi) < kmin) S[jb][rg] = -INFINITY; }
      } }
    __builtin_amdgcn_sched_barrier(0);
    float mx = -INFINITY;
#pragma unroll
    for (int jb = 0; jb < 5; ++jb)
#pragma unroll
        for (int rg = 0; rg < 16; ++rg) mx = fmaxf(mx, S[jb][rg]);
    { auto rr = __builtin_amdgcn_permlane32_swap(__float_as_uint(mx), __float_as_uint(mx), false, false); mx = fmaxf(__uint_as_float(rr[0]), __uint_as_float(rr[1])); }
    float l = 0.f;
#pragma unroll
    for (int jb = 0; jb < 5; ++jb)
#pragma unroll
        for (int rg = 0; rg < 16; ++rg) { const float p = __builtin_amdgcn_exp2f(S[jb][rg] - mx); S[jb][rg] = p; l += p; }
    { auto rr = __builtin_amdgcn_permlane32_swap(__float_as_uint(l), __float_as_uint(l), false, false); l = __uint_as_float(rr[0]) + __uint_as_float(rr[1]); }
    f32x16v o0 = {}, o1 = {};
    const LAS unsigned char* vbase = lds + CV_OFF + ((lane >> 4) & 1) * 32 + (lane & 3) * 8 + (32 * wid + 4 * hi + ((lane & 15) >> 2)) * 64;
#pragma unroll
    for (int jb = 0; jb < 5; ++jb)
#pragma unroll
        for (int s2 = 0; s2 < 2; ++s2) {
            pg8::u32x4 pw; pw.x = pg8::cvt_pk_bf16(S[jb][8 * s2 + 0], S[jb][8 * s2 + 1]); pw.y = pg8::cvt_pk_bf16(S[jb][8 * s2 + 2], S[jb][8 * s2 + 3]);
            pw.z = pg8::cvt_pk_bf16(S[jb][8 * s2 + 4], S[jb][8 * s2 + 5]); pw.w = pg8::cvt_pk_bf16(S[jb][8 * s2 + 6], S[jb][8 * s2 + 7]);
            const bf16x8 pa = __builtin_bit_cast(bf16x8, pw);
            const LAS unsigned char* vp = vbase + (32 * jb + 16 * s2) * 64;
            const s16x4v a0 = vtr16(vp), a1 = vtr16(vp + 512), c0 = vtr16(vp + CV_HALF), c1 = vtr16(vp + CV_HALF + 512);
            const bf16x8 v0 = (bf16x8){a0[0], a0[1], a0[2], a0[3], a1[0], a1[1], a1[2], a1[3]}, v1 = (bf16x8){c0[0], c0[1], c0[2], c0[3], c1[0], c1[1], c1[2], c1[3]};
            o0 = __builtin_amdgcn_mfma_f32_32x32x16_bf16(pa, v0, o0, 0, 0, 0); o1 = __builtin_amdgcn_mfma_f32_32x32x16_bf16(pa, v1, o1, 0, 0, 0); }
    LAS float* scr = (LAS float*)(lds + CS_OFF) + wid * 32;
    if (hi == 0) { scr[r32] = l; LSE[qtok * 4 + h] = mx + __builtin_amdgcn_logf(l); }
    LDS_WAIT(); asm volatile("" ::: "memory");
#pragma unroll
    for (int rg = 0; rg < 16; ++rg) { const int q = crow16(rg, hi); const float il = __builtin_amdgcn_rcpf(scr[q]);
        bf16* op = OC + (tok0 + ((size_t)(m0 + 32 * wid + q) << sh) + r) * 256 + h * 64 + r32;
        op[0] = (bf16)f2bf(o0[rg] * il); op[32] = (bf16)f2bf(o1[rg] * il); }
    __syncthreads();
}

template <int W> __device__ __forceinline__ void pool_run(const float (&pin)[47], int sbase, bf16* yo) {
#pragma unroll
    for (int i = 0; i < 32; ++i) { float s = 0.f;
#pragma unroll
        for (int j = 0; j < W; ++j) s += pin[15 + i - j];
        const int pos = sbase + i; const float cnt = (float)((pos + 1 < W) ? pos + 1 : W);
        yo[(size_t)i * DM] = (bf16)f2bf(s / cnt - pin[15 + i]); }
}
__device__ __forceinline__ void ab_unit(int unit, const float* dww, const float* dwb, const float* lng, const float* lnb, const bf16* Z, const bf16* UBp, bf16* Y, LAS unsigned char* lds, int tid, int lane, int wid) {
    const int b = unit >> 6, s0 = (unit & 63) * 64, c = tid & 255, half = tid >> 8, sbase = s0 + 32 * half;
    const size_t tok0 = (size_t)b * SEQ;
    LAS float* cv = (LAS float*)lds;
    { float w[CONVW];
#pragma unroll
      for (int j = 0; j < CONVW; ++j) w[j] = dww[j * GW + c];
      const float bias = dwb[c];
      float zin[62];
#pragma unroll
      for (int i = 0; i < 62; ++i) { const int s = sbase - 30 + i; zin[i] = (s >= 0) ? bf2f(Z[(tok0 + (s >= 0 ? s : 0)) * 256 + c]) : 0.f; }
#pragma unroll
      for (int i = 0; i < 32; ++i) { float a = bias;
#pragma unroll
          for (int j = 0; j < CONVW; ++j) a += w[j] * zin[i + j];
          cv[(32 * half + i) * 256 + c] = a; } }
    asm volatile("" ::: "memory"); __builtin_amdgcn_sched_barrier(0);
    { float pin[47];
#pragma unroll
      for (int i = 0; i < 47; ++i) { const int s = sbase - 15 + i; pin[i] = (s >= 0) ? bf2f(UBp[(tok0 + (s >= 0 ? s : 0)) * 256 + c]) : 0.f; }
      bf16* yo = Y + (tok0 + sbase) * DM + 256 + c;
      const int g = (c >> 6);
      if (g == 0) pool_run<2>(pin, sbase, yo); else if (g == 1) pool_run<4>(pin, sbase, yo); else if (g == 2) pool_run<8>(pin, sbase, yo); else pool_run<16>(pin, sbase, yo); }
    __syncthreads();
    { const f32x4 g4 = *(const f32x4*)(lng + 4 * lane), b4 = *(const f32x4*)(lnb + 4 * lane);
#pragma unroll
      for (int pp = 0; pp < 8; ++pp) { const int pos = 8 * wid + pp; const f32x4 v = *(const LAS f32x4*)(cv + pos * 256 + 4 * lane);
          const float mu = wave_sum((v.x + v.y) + (v.z + v.w)) * (1.0f / 256.0f); const f32x4 d = v - mu;
          const float var = wave_sum((d.x * d.x + d.y * d.y) + (d.z * d.z + d.w * d.w)) * (1.0f / 256.0f); const float rs = 1.0f / sqrtf(var + 1e-5f);
          f32x4 y = d * rs * g4 + b4; y.x *= pg8::sigm(y.x); y.y *= pg8::sigm(y.y); y.z *= pg8::sigm(y.z); y.w *= pg8::sigm(y.w);
          v2u w; w.x = pg8::cvt_pk_bf16(y.x, y.y); w.y = pg8::cvt_pk_bf16(y.z, y.w);
          *(GAS v2u*)(Y + (tok0 + s0 + pos) * DM + 4 * lane) = w; } }
    __syncthreads();
}

__device__ __forceinline__ void comb_phase(const bf16* OC, const float* LSE, const bf16* OD, bf16* Y, const float* dg, float lam, float omli, int gw, int NGW, int lane) {
    const int h = lane >> 4, d4 = (lane & 15) * 4; const f32x4 g4 = *(const f32x4*)(dg + d4);
    for (int t = gw; t < T; t += NGW) {
        { const float l0 = LSE[(size_t)t * 4 + h], l1 = LSE[((size_t)T + t) * 4 + h], l2 = LSE[((size_t)2 * T + t) * 4 + h]; const float mx = fmaxf(fmaxf(l0, l1), l2);
          float w0 = __builtin_amdgcn_exp2f(l0 - mx), w1 = __builtin_amdgcn_exp2f(l1 - mx), w2 = __builtin_amdgcn_exp2f(l2 - mx); const float inv = 1.0f / (w0 + w1 + w2); w0 *= inv; w1 *= inv; w2 *= inv;
          const v2u a = *(const GAS v2u*)(OC + (size_t)t * 256 + 4 * lane), bq = *(const GAS v2u*)(OC + ((size_t)T + t) * 256 + 4 * lane), cq = *(const GAS v2u*)(OC + ((size_t)2 * T + t) * 256 + 4 * lane);
          const float y0 = w0 * __uint_as_float(a.x << 16) + w1 * __uint_as_float(bq.x << 16) + w2 * __uint_as_float(cq.x << 16);
          const float y1 = w0 * __uint_as_float(a.x & 0xffff0000u) + w1 * __uint_as_float(bq.x & 0xffff0000u) + w2 * __uint_as_float(cq.x & 0xffff0000u);
          const float y2 = w0 * __uint_as_float(a.y << 16) + w1 * __uint_as_float(bq.y << 16) + w2 * __uint_as_float(cq.y << 16);
          const float y3 = w0 * __uint_as_float(a.y & 0xffff0000u) + w1 * __uint_as_float(bq.y & 0xffff0000u) + w2 * __uint_as_float(cq.y & 0xffff0000u);
          v2u w; w.x = pg8::cvt_pk_bf16(y0, y1); w.y = pg8::cvt_pk_bf16(y2, y3); *(GAS v2u*)(Y + (size_t)t * DM + 512 + 4 * lane) = w; }
        { const v2u a = *(const GAS v2u*)(OD + (size_t)t * 512 + h * 128 + d4), bq = *(const GAS v2u*)(OD + (size_t)t * 512 + h * 128 + 64 + d4);
          const float o0 = __uint_as_float(a.x << 16) - lam * __uint_as_float(bq.x << 16), o1 = __uint_as_float(a.x & 0xffff0000u) - lam * __uint_as_float(bq.x & 0xffff0000u);
          const float o2 = __uint_as_float(a.y << 16) - lam * __uint_as_float(bq.y << 16), o3 = __uint_as_float(a.y & 0xffff0000u) - lam * __uint_as_float(bq.y & 0xffff0000u);
          float s = (o0 * o0 + o1 * o1) + (o2 * o2 + o3 * o3); s += __shfl_xor(s, 1); s += __shfl_xor(s, 2); s += __shfl_xor(s, 4); s += __shfl_xor(s, 8);
          const float rs = omli / sqrtf(s * (1.0f / 64.0f) + 1e-5f);
          v2u w; w.x = pg8::cvt_pk_bf16(o0 * rs * g4.x, o1 * rs * g4.y); w.y = pg8::cvt_pk_bf16(o2 * rs * g4.z, o3 * rs * g4.w); *(GAS v2u*)(Y + (size_t)t * DM + 768 + 4 * lane) = w; }
    }
}

__device__ __forceinline__ void route_phase(const float* x, const float* g2, const float* router, unsigned char* ws, LAS unsigned char* lds, int vcu, int G, int tid, int lane, int wave) {
    LAS float* rt = (LAS float*)lds; LAS int* cnt = (LAS int*)(lds + 32768); LAS int* base = cnt + 8;
    for (int i = tid; i < NE * DM; i += NWAVES * 64) { const int e = i >> 10, k = i & 1023; rt[i] = g2[k] * router[k * NE + e]; }
    if (tid < NE) cnt[tid] = 0;
    __syncthreads();
    const int gw = vcu * NWAVES + wave, NGW = G * NWAVES;
    int* toke = (int*)(ws + WS_TOKE); float* tokg = (float*)(ws + WS_TOKG); int* tokp = (int*)(ws + WS_TOKP); float* sst = (float*)(ws + WS_SST);
    for (int t = gw; t < T; t += NGW) {
        const GAS f32x4* xr = (const GAS f32x4*)(x + (size_t)t * DM) + lane; float ss = 0.f, a[NE];
#pragma unroll
        for (int e = 0; e < NE; ++e) a[e] = 0.f;
#pragma unroll
        for (int j = 0; j < 4; ++j) { const f32x4 v = xr[64 * j]; ss += (v.x * v.x + v.y * v.y) + (v.z * v.z + v.w * v.w);
#pragma unroll
            for (int e = 0; e < NE; ++e) { const f32x4 w = *(const LAS f32x4*)(rt + e * DM + 256 * j + 4 * lane); a[e] += (v.x * w.x + v.y * w.y) + (v.z * w.z + v.w * w.w); } }
        ss = wave_sum(ss);
#pragma unroll
        for (int e = 0; e < NE; ++e) a[e] = wave_sum(a[e]);
        const float rs = 1.0f / sqrtf(ss * (1.0f / 1024.0f) + 1e-5f);
        int i0 = 0; float v0 = a[0];
#pragma unroll
        for (int e = 1; e < NE; ++e) if (a[e] > v0) { v0 = a[e]; i0 = e; }
        int i1 = -1; float v1 = -INFINITY;
#pragma unroll
        for (int e = 0; e < NE; ++e) if (e != i0 && a[e] > v1) { v1 = a[e]; i1 = e; }
        const float g0 = 1.0f / (1.0f + expf((v1 - v0) * rs)), g1 = 1.0f - g0;
        if (lane == 0) { const int r0 = __hip_atomic_fetch_add(cnt + i0, 1, __ATOMIC_RELAXED, __HIP_MEMORY_SCOPE_WORKGROUP), r1 = __hip_atomic_fetch_add(cnt + i1, 1, __ATOMIC_RELAXED, __HIP_MEMORY_SCOPE_WORKGROUP);
            toke[2 * t] = i0; toke[2 * t + 1] = i1; tokg[2 * t] = g0; tokg[2 * t + 1] = g1; tokp[2 * t] = r0; tokp[2 * t + 1] = r1; sst[t] = ss; }
    }
    VM_WAIT(); __syncthreads();
    if (tid < NE) base[tid] = (int)__hip_atomic_fetch_add((unsigned*)(ws + WS_CTL) + CW_ECNT + 64 * tid, (unsigned)cnt[tid], __ATOMIC_RELAXED, __HIP_MEMORY_SCOPE_AGENT);
    __syncthreads();
    { const int t = gw + lane * NGW; if (t < T) { tokp[2 * t] += base[toke[2 * t]]; tokp[2 * t + 1] += base[toke[2 * t + 1]]; } }
    __syncthreads();
}
struct MoeTiles { int ts[9]; };
__device__ __forceinline__ MoeTiles moe_tiles(const unsigned char* ws) {
    MoeTiles m; int acc = 0;
#pragma unroll
    for (int e = 0; e < NE; ++e) { m.ts[e] = acc; const unsigned c = (unsigned)__builtin_amdgcn_readfirstlane((int)__hip_atomic_load((const unsigned*)(ws + WS_CTL) + CW_ECNT + 64 * e, __ATOMIC_RELAXED, __HIP_MEMORY_SCOPE_AGENT)); acc += (int)((c + 255u) >> 8); }
    m.ts[8] = acc; return m;
}
__device__ __forceinline__ void gather_phase(unsigned char* ws, int gw, int NGW, int lane) {
    const MoeTiles mt = moe_tiles(ws);
    const int* toke = (const int*)(ws + WS_TOKE); int* tokp = (int*)(ws + WS_TOKP); const float* sst = (const float*)(ws + WS_SST); float* ssrow = (float*)(ws + WS_SSROW);
    const bf16* xb = (const bf16*)(ws + WS_XB); bf16* hs = (bf16*)(ws + WS_HS);
    for (int t = gw; t < T; t += NGW) {
        const int e0 = toke[2 * t], e1 = toke[2 * t + 1];
        int o0 = 0, o1 = 0;
#pragma unroll
        for (int e = 0; e < NE; ++e) { if (e == e0) o0 = mt.ts[e]; if (e == e1) o1 = mt.ts[e]; }
        const int p0 = o0 * 256 + tokp[2 * t], p1 = o1 * 256 + tokp[2 * t + 1];
        const GAS v4u* src = (const GAS v4u*)(xb + (size_t)t * DM) + lane; const v4u a = src[0], c = src[64];
        GAS v4u* d0 = (GAS v4u*)(hs + (size_t)p0 * DM) + lane; GAS v4u* d1 = (GAS v4u*)(hs + (size_t)p1 * DM) + lane;
        d0[0] = a; d0[64] = c; d1[0] = a; d1[64] = c;
        if (lane == 0) { const float s = sst[t]; ssrow[p0] = s; ssrow[p1] = s; tokp[2 * t] = p0; tokp[2 * t + 1] = p1; }
    }
}
__device__ __forceinline__ void final_phase(float* xo, const float* fg, const unsigned char* ws, int gw, int NGW, int lane) {
    const int* tokp = (const int*)(ws + WS_TOKP); const float* tokg = (const float*)(ws + WS_TOKG); const bf16* y2 = (const bf16*)(ws + WS_HS);
    for (int t = gw; t < T; t += NGW) {
        const int p0 = tokp[2 * t], p1 = tokp[2 * t + 1]; const float g0 = tokg[2 * t], g1 = tokg[2 * t + 1];
        GAS f32x4* xr = (GAS f32x4*)(xo + (size_t)t * DM) + lane; const GAS v2u* ya = (const GAS v2u*)(y2 + (size_t)p0 * DM) + lane; const GAS v2u* yb = (const GAS v2u*)(y2 + (size_t)p1 * DM) + lane;
        f32x4 v[4]; float ss = 0.f;
#pragma unroll
        for (int j = 0; j < 4; ++j) { const f32x4 xv = xr[64 * j]; const v2u a = ya[64 * j], c = yb[64 * j];
            v[j].x = xv.x + g0 * __uint_as_float(a.x << 16) + g1 * __uint_as_float(c.x << 16); v[j].y = xv.y + g0 * __uint_as_float(a.x & 0xffff0000u) + g1 * __uint_as_float(c.x & 0xffff0000u);
            v[j].z = xv.z + g0 * __uint_as_float(a.y << 16) + g1 * __uint_as_float(c.y << 16); v[j].w = xv.w + g0 * __uint_as_float(a.y & 0xffff0000u) + g1 * __uint_as_float(c.y & 0xffff0000u);
            ss += (v[j].x * v[j].x + v[j].y * v[j].y) + (v[j].z * v[j].z + v[j].w * v[j].w); }
        ss = wave_sum(ss); const float rs = 1.0f / sqrtf(ss * (1.0f / 1024.0f) + 1e-5f);
#pragma unroll
        for (int j = 0; j < 4; ++j) { const f32x4 g = *(const f32x4*)(fg + 256 * j + 4 * lane); xr[64 * j] = v[j] * rs * g; }
    }
}
__device__ __forceinline__ unsigned char* opq(unsigned char* p) { asm volatile("" : "+s"(p)); return p; }
struct Args { const float* in[22]; float* out; unsigned char* ws; int ph_lo, ph_hi; };
#ifndef PHASE_MASK
#define PHASE_MASK 0xFFFFFu
#endif
#ifndef MIX_MASK
#define MIX_MASK 7
#endif
__global__ void __launch_bounds__(NWAVES * 64, 2) hymba_fwd(Args args) {
    extern __shared__ __attribute__((aligned(16))) unsigned char lds_raw[];
    LAS unsigned char* lds = (LAS unsigned char*)lds_raw;
    volatile LAS unsigned* MISC = (volatile LAS unsigned*)(lds + MISC_OFF);
    for (int u = threadIdx.x; u < (LDS_BYTES - LDSCTL_OFF) / 4; u += NWAVES * 64) ((LAS unsigned*)(lds + LDSCTL_OFF))[u] = 0u;
    __syncthreads();
    if (threadIdx.x == 0) {
#pragma unroll
        for (int i = 0; i < 22; ++i) ((LAS unsigned long long*)(lds + LDSCTL_OFF))[i] = (unsigned long long)args.in[i];
        ((LAS unsigned long long*)(lds + LDSCTL_OFF))[22] = (unsigned long long)args.out; ((LAS unsigned long long*)(lds + LDSCTL_OFF))[23] = (unsigned long long)args.ws;
    }
    __syncthreads();
    XcdBarrier bar; bar.bar = nullptr; bar.x = 0; bar.st = MISC + 8;
    if (!MK_PER_PHASE) bar = xcd_barrier_post((unsigned*)((unsigned char*)inp(lds, 23) + WS_CTL) + CW_BAR, MISC + 8);
    MISC[10] = bar.x;
#if MK_PER_PHASE
    MISC[11] = (unsigned)args.ph_lo; MISC[12] = (unsigned)args.ph_hi;
#define IN(k) (((PHASE_MASK >> (k)) & 1u) && (int)MISC[11] <= (k) && (k) < (int)MISC[12])
#define SEAM(k) do { } while (0)
#else
#define IN(k) ((PHASE_MASK >> (k)) & 1u)
#define SEAM(k) do { XcdBarrier b2_; b2_.bar = (unsigned*)((unsigned char*)inp(lds, 23) + WS_CTL) + CW_BAR; b2_.x = __builtin_amdgcn_readfirstlane(MISC[10]); b2_.st = MISC + 8; xcd_barrier(b2_); } while (0)
#endif
#define PHASE_CTX \
    int tid = threadIdx.x; asm volatile("" : "+v"(tid)); const int lane = tid & 63, wave = __builtin_amdgcn_readfirstlane(tid >> 6); \
    int G = gridDim.x, bx = blockIdx.x; asm volatile("" : "+s"(G), "+s"(bx)); const int vcu = (G % 8 == 0) ? (bx % 8) * (G / 8) + bx / 8 : bx; \
    const int gw = vcu * NWAVES + wave, NGW = G * NWAVES; \
    unsigned char* const ws = (unsigned char*)inp(lds, 23); float* const xo = (float*)inp(lds, 22); \
    bf16* XB = (bf16*)(ws + WS_XB); bf16* UB = (bf16*)(ws + WS_UB); bf16* QD = (bf16*)(ws + WS_QD); bf16* Y = (bf16*)(ws + WS_Y); bf16* OC = (bf16*)(ws + WS_OC); float* LSE = (float*)(ws + WS_LSE); \
    (void)lane; (void)wave; (void)vcu; (void)gw; (void)NGW; (void)xo; (void)XB; (void)UB; (void)QD; (void)Y; (void)OC; (void)LSE;

    if (IN(0)) { PHASE_CTX p0_prologue(ws, lds, vcu, G, tid, lane, wave); }
    SEAM(0);

#define LAYER_COMMON(l, pb) \
    if (IN(pb)) { PHASE_CTX \
        pg8::Gemm g{XB, (const bf16*)(ws + WS_WIN + (l) * SZ_WIN), T, NIN, DM}; pg8::StaticOrder S; S.init(T, NIN, G, bx); \
        pg8::EpiIn<(l) != 0> E{(const float*)(ws + ((l) == 0 ? WS_SS0 : WS_SSP)), UB, QD, (const float*)(ws + WS_ROPEC), (const float*)(ws + WS_ROPED), (size_t)T * 256}; \
        pg8::gemm_phase<pg8::EpiIn<(l) != 0>, pg8::StaticOrder, true, true>(lds + RING_OFF, g, S, E); \
    } \
    SEAM(pb); \
    if (IN((pb) + 1)) { \
        if (MIX_MASK & 1) { PHASE_CTX \
          const bf16* KD = UB + (size_t)5 * T * 256; const bf16* VD = UB + (size_t)6 * T * 256; \
          for (int i = 0; ; ++i) { \
            int pair, qb; \
            if (G == 256) { if (i >= 4) break; const int s = vcu & 3; pair = vcu >> 2; qb = (i == 0) ? s : (i == 1) ? 7 - s : (i == 2) ? 8 + s : 15 - s; } \
            else { const int id = i * G + vcu; if (id >= 1024) break; pair = id >> 4; qb = id & 15; } \
            attn_body::attn_unit<8>(pair >> 3, pair & 7, qb, (const attn_body::bf16*)QD, (const attn_body::bf16*)KD, (const attn_body::bf16*)VD, (attn_body::bf16*)QD, (char*)lds_raw + RING_OFF); \
          } \
          __syncthreads(); } \
        if (MIX_MASK & 2) { PHASE_CTX for (int uc = vcu; uc < 1536; uc += G) dil_unit(uc, UB + (size_t)2 * T * 256, UB + (size_t)3 * T * 256, UB + (size_t)4 * T * 256, OC, LSE, lds + RING_OFF, tid, lane, wave); } \
        if (MIX_MASK & 4) { PHASE_CTX for (int un = vcu; un < 512; un += G) ab_unit(un, IN_(3) + (l) * CONVW * GW, IN_(4) + (l) * GW, IN_(5) + (l) * GW, IN_(6) + (l) * GW, UB, UB + (size_t)T * 256, Y, lds + RING_OFF, tid, lane, wave); } \
    } \
    SEAM((pb) + 1); \
    if (IN((pb) + 2)) { PHASE_CTX const float* mi = (const float*)(ws + WS_MISC); comb_phase(OC, LSE, QD, Y, IN_(11) + (l) * 64, mi[2 * (l)], mi[2 * (l) + 1], gw, NGW, lane); } \
    SEAM((pb) + 2); \
    if (IN((pb) + 3)) { PHASE_CTX \
        pg8::Gemm g{Y, (const bf16*)(ws + WS_WOUT + (l) * SZ_WOUT), T, DM, DM}; pg8::StaticOrder S; S.init(T, DM, G, bx); \
        pg8::EpiRes<(l) == 0> E{(l) == 0 ? IN_(0) : (const float*)xo, xo, XB, (float*)(ws + WS_SSP)}; pg8::gemm_phase<pg8::EpiRes<(l) == 0>, pg8::StaticOrder, true, true>(lds + RING_OFF, g, S, E); \
    } \
    SEAM((pb) + 3);

    LAYER_COMMON(0, 1)
    if (IN(5)) { PHASE_CTX
        pg8::Gemm g{XB, (const bf16*)(ws + WS_W1), T, 2 * DFF, DM}; pg8::StaticOrder S; S.init(T, 2 * DFF, G, bx);
        pg8::EpiGlu<true> E{(bf16*)(ws + WS_HID), DFF, (const float*)(ws + WS_SSP), 0};
        pg8::gemm_phase<pg8::EpiGlu<true>, pg8::StaticOrder, true, true>(lds + RING_OFF, g, S, E);
    }
    SEAM(5);
    if (IN(6)) { PHASE_CTX
        pg8::Gemm g{(const bf16*)(ws + WS_HID), (const bf16*)(ws + WS_W2), T, DM, DFF}; pg8::StaticOrder S; S.init(T, DM, G, bx);
        pg8::EpiRes<true> E{xo, xo, XB, (float*)(ws + WS_SSP)};
        pg8::gemm_phase<pg8::EpiRes<true>, pg8::StaticOrder, true, true>(lds + RING_OFF, g, S, E);
    }
    SEAM(6);
    LAYER_COMMON(1, 7)
#undef LAYER_COMMON
    if (IN(11)) { PHASE_CTX route_phase(xo, IN_(13) + DM, IN_(17), ws, lds + RING_OFF, vcu, G, tid, lane, wave); }
    SEAM(11);
    if (IN(12)) { PHASE_CTX gather_phase(ws, gw, NGW, lane); }
    SEAM(12);
#pragma unroll
    for (int c = 0; c < MOE_NCHUNK; ++c) {
        if (IN(13 + 2 * c)) { PHASE_CTX
            const MoeTiles mt = moe_tiles(ws); int nm = mt.ts[8] - c * MOE_CHUNK_TILES; nm = nm < 0 ? 0 : (nm > MOE_CHUNK_TILES ? MOE_CHUNK_TILES : nm);
            pg8::Gemm g{(const bf16*)(ws + WS_HS), (const bf16*)(ws + WS_W1E), nm * 256, 2 * DFE, DM};
            pg8::MoeOrder S; S.init(nm * 256, 2 * DFE, G, bx); S.tile0 = c * MOE_CHUNK_TILES; S.a_off = 0; S.ts1 = mt.ts[1]; S.ts2 = mt.ts[2]; S.ts3 = mt.ts[3]; S.ts4 = mt.ts[4]; S.ts5 = mt.ts[5]; S.ts6 = mt.ts[6]; S.ts7 = mt.ts[7]; S.estride = SZ_W1E;
            pg8::EpiGlu<false> E{(bf16*)(ws + WS_HIDE), DFE, (const float*)(ws + WS_SSROW), c * MOE_CHUNK_TILES};
            pg8::gemm_phase<pg8::EpiGlu<false>, pg8::MoeOrder, true, true>(lds + RING_OFF, g, S, E);
        }
        SEAM(13 + 2 * c);
        if (IN(14 + 2 * c)) { PHASE_CTX
            const MoeTiles mt = moe_tiles(ws); int nm = mt.ts[8] - c * MOE_CHUNK_TILES; nm = nm < 0 ? 0 : (nm > MOE_CHUNK_TILES ? MOE_CHUNK_TILES : nm);
            pg8::Gemm g{(const bf16*)(ws + WS_HIDE), (const bf16*)(ws + WS_W2E), nm * 256, DM, DFE};
            pg8::MoeOrder S; S.init(nm * 256, DM, G, bx); S.tile0 = c * MOE_CHUNK_TILES; S.a_off = c * MOE_CHUNK_TILES; S.ts1 = mt.ts[1]; S.ts2 = mt.ts[2]; S.ts3 = mt.ts[3]; S.ts4 = mt.ts[4]; S.ts5 = mt.ts[5]; S.ts6 = mt.ts[6]; S.ts7 = mt.ts[7]; S.estride = SZ_W2E;
            pg8::EpiY E{(bf16*)(ws + WS_HS)};
            pg8::gemm_phase<pg8::EpiY, pg8::MoeOrder, true, true>(lds + RING_OFF, g, S, E);
        }
        SEAM(14 + 2 * c);
    }
    if (IN(19)) { PHASE_CTX final_phase(xo, IN_(21), ws, gw, NGW, lane); }
#undef IN
#undef SEAM
#undef PHASE_CTX
}

extern "C" void kernel_launch(void* const* d_in, const int* in_sizes, int n_in, void* d_out, int out_size, void* d_ws, size_t ws_size, hipStream_t stream) {
    static int grid = 0;
    if (grid == 0) {
        if (n_in != 22 || in_sizes[0] != T * DM || out_size != T * DM || ws_size < WS_END) { fprintf(stderr, "kernel_launch: unexpected shapes (n_in %d, ws %zu, need %zu); nothing launched\n", n_in, ws_size, (size_t)WS_END); grid = -1; return; }
        int dev = 0, cus = 0;
        if (hipGetDevice(&dev) != hipSuccess || hipDeviceGetAttribute(&cus, hipDeviceAttributeMultiprocessorCount, dev) != hipSuccess) { grid = -1; return; }
        if (hipFuncSetAttribute((const void*)hymba_fwd, hipFuncAttributeMaxDynamicSharedMemorySize, LDS_BYTES) != hipSuccess) { fprintf(stderr, "kernel_launch: hipFuncSetAttribute failed\n"); grid = -1; return; }
        int per_cu = 0;
        if (hipOccupancyMaxActiveBlocksPerMultiprocessor(&per_cu, (const void*)hymba_fwd, NWAVES * 64, LDS_BYTES) != hipSuccess || per_cu < 1) fprintf(stderr, "kernel_launch: note: occupancy query reports %d\n", per_cu);
        (void)hipGetLastError();
        grid = cus;
    }
    if (grid < 0) return;
    if (hipMemsetAsync((char*)d_ws + WS_CTL, 0, CTL_ZERO_BYTES, stream) != hipSuccess) return;
    Args a{};
    for (int i = 0; i < 22; ++i) a.in[i] = (const float*)d_in[i];
    a.out = (float*)d_out; a.ws = (unsigned char*)d_ws;
#if MK_PER_PHASE
    for (int p = 0; p < N_PHASES; ++p) { a.ph_lo = p; a.ph_hi = p + 1; hipLaunchKernelGGL(hymba_fwd, dim3(grid), dim3(NWAVES * 64), LDS_BYTES, stream, a); }
#else
    a.ph_lo = 0; a.ph_hi = N_PHASES;
    hipLaunchKernelGGL(hymba_fwd, dim3(grid), dim3(NWAVES * 64), LDS_BYTES, stream, a);
#endif
}
```

```cpp
#include <hip/hip_runtime.h>
#include <hip/hip_bf16.h>
#include <cstdio>
#include <cstdint>
#include <cmath>
namespace pg8 {
#define PG8_LAS __attribute__((address_space(3)))
typedef unsigned short bf16_t;
typedef short bf16x8 __attribute__((ext_vector_type(8)));
typedef float f32x4 __attribute__((ext_vector_type(4)));
typedef unsigned u32x4 __attribute__((ext_vector_type(4)));
typedef unsigned u32x2 __attribute__((ext_vector_type(2)));
constexpr int BM = 256, BK = 64, HALF = 128, HTB = HALF * BK * 2  , STAGE_BYTES = 8 * HTB, NXCD = 8, WGM = 8;

__host__ __device__ __forceinline__ int lds_byte(int r, int c) { const int st = (r >> 4) * 2 + (c >> 5), rr = r & 15, cc = c & 31, ob = rr * 64 + cc * 2; return st * 1024 + (ob ^ (((ob >> 9) & 1) << 5)); }
__host__ __device__ __forceinline__ void stage_rc(int b, int& R, int& C) { const int st = b / 1024, sb = b % 1024, swz = sb ^ (((sb >> 9) & 1) << 5); R = (st >> 1) * 16 + swz / 64; C = (st & 1) * 32 + (swz % 64) / 2; }
__host__ __device__ __forceinline__ int perm32(int rho) { const int n = rho >> 4, i = rho & 15; return 8 * (i >> 2) + 4 * n + (i & 3); }

struct Unit { int pm, pn; };
struct Gemm { const bf16_t* A; const bf16_t* Bt; int M, N, K; };

struct StaticOrder {
    int nM, nN, nwg, G, c;
    __host__ __device__ void init(int M, int N, int G_, int c_) { nM = M / BM; nN = N / BM; nwg = nM * nN; G = G_; c = c_; }
    __host__ __device__ bool next(int i, Unit& u) const {
        const long L = (long)i * G + c; if (L >= nwg) return false;
        int wgid = (int)L; { const int q = nwg / NXCD, r = nwg % NXCD, xcd = wgid % NXCD, off = wgid / NXCD; wgid = (xcd < r ? xcd * (q + 1) : r * (q + 1) + (xcd - r) * q) + off; }
        const int nig = WGM * nN, gid = wgid / nig, fm = gid * WGM, gsz = (nM - fm) < WGM ? (nM - fm) : WGM;
        u.pm = fm + ((wgid % nig) % gsz); u.pn = (wgid % nig) / gsz; return true;
    }
    __device__ __forceinline__ const char* a_ptr(const Gemm& g, const Unit& u) const { return (const char*)g.A + (size_t)u.pm * ((size_t)BM * g.K * 2); }
    __device__ __forceinline__ const char* b_ptr(const Gemm& g, const Unit& u) const { return (const char*)g.Bt + (size_t)u.pn * ((size_t)BM * g.K * 2); }
    __device__ __forceinline__ void a_ready(const Unit&) const {}
    __device__ __forceinline__ void done(const Unit&) const {}
};
struct MoeOrder : StaticOrder {
    int tile0, a_off; int ts1, ts2, ts3, ts4, ts5, ts6, ts7; size_t estride;
    int lev_r, lev_d;
    __device__ __forceinline__ bool next(int i, Unit& u) const {
        long L;
        if (lev_d == 0) L = (long)i * G + c;
        else { const long E = (long)(G - lev_r) * lev_d; L = (c >= lev_r) ? ((i < lev_d) ? (long)(c - lev_r) * lev_d + i : E + (long)(i - lev_d) * G + c) : E + (long)i * G + c; }
        if (L >= nwg) return false;
        int wgid = (int)L; { const int q = nwg / NXCD, r = nwg % NXCD, xcd = wgid % NXCD, off = wgid / NXCD; wgid = (xcd < r ? xcd * (q + 1) : r * (q + 1) + (xcd - r) * q) + off; }
        const int nig = WGM * nN, gid = wgid / nig, fm = gid * WGM, gsz = (nM - fm) < WGM ? (nM - fm) : WGM;
        u.pm = fm + ((wgid % nig) % gsz) + tile0; u.pn = (wgid % nig) / gsz; return true;
    }
    __device__ __forceinline__ int expert(int pm) const { return (pm >= ts1) + (pm >= ts2) + (pm >= ts3) + (pm >= ts4) + (pm >= ts5) + (pm >= ts6) + (pm >= ts7); }
    __device__ __forceinline__ const char* a_ptr(const Gemm& g, const Unit& u) const { return (const char*)g.A + (size_t)(u.pm - a_off) * ((size_t)BM * g.K * 2); }
    __device__ __forceinline__ const char* b_ptr(const Gemm& g, const Unit& u) const { return (const char*)g.Bt + (size_t)expert(u.pm) * estride + (size_t)u.pn * ((size_t)BM * g.K * 2); }
};

__device__ __forceinline__ unsigned cvt_pk_bf16(float lo, float hi) { unsigned r; asm volatile("v_cvt_pk_bf16_f32 %0, %1, %2" : "=v"(r) : "v"(lo), "v"(hi)); return r; }
__device__ __forceinline__ u32x4 pack8(const f32x4 v0, const f32x4 v1) { u32x4 w; w.x = cvt_pk_bf16(v0[0], v0[1]); w.y = cvt_pk_bf16(v0[2], v0[3]); w.z = cvt_pk_bf16(v1[0], v1[1]); w.w = cvt_pk_bf16(v1[2], v1[3]); return w; }
__device__ __forceinline__ float sigm(float b) { return __builtin_amdgcn_rcpf(1.0f + __builtin_amdgcn_exp2f(-1.4426950408889634f * b)); }
constexpr float RMS_EPS = 1e-5f;
constexpr float F8_ACT = 8.0f, F8_WGT = 64.0f, F8_INV = 1.0f / 512.0f, Y_SCALE = 16.0f;
__device__ __forceinline__ float clamp8(float v) { return __builtin_fminf(__builtin_fmaxf(v, -448.0f), 448.0f); }
__device__ __forceinline__ unsigned pack4_fp8(float a, float b, float c, float d) {
    int w = __builtin_amdgcn_cvt_pk_fp8_f32(__builtin_amdgcn_fmed3f(a, -448.0f, 448.0f), __builtin_amdgcn_fmed3f(b, -448.0f, 448.0f), 0, false);
    w = __builtin_amdgcn_cvt_pk_fp8_f32(__builtin_amdgcn_fmed3f(c, -448.0f, 448.0f), __builtin_amdgcn_fmed3f(d, -448.0f, 448.0f), w, true); return (unsigned)w; }

constexpr float SCALE_C = 0.125f * 1.4426950408889634f;
constexpr float SCALE_D = 0.17677669529663687f * 1.4426950408889634f;

__device__ __forceinline__ void st16_rowpair(u32x2 a, u32x2 b, unsigned char* p) {
    asm volatile("s_nop 1" : "+v"(a.x), "+v"(a.y), "+v"(b.x), "+v"(b.y));
    const auto r0 = __builtin_amdgcn_permlane16_swap(a.x, b.x, false, false); const auto r1 = __builtin_amdgcn_permlane16_swap(a.y, b.y, false, false);
    *(u32x4*)p = (u32x4){r0[0], r1[0], r0[1], r1[1]};
}
template <bool PARTS> __device__ __forceinline__ f32x4 rsum_ld(const float* ss, int row, int fq) {
    if (!PARTS) { const float v = ss[row]; return (f32x4){v, 0.f, 0.f, 0.f}; }
    return *((const f32x4*)(ss + (size_t)row * 16) + fq);
}
template <bool PARTS> __device__ __forceinline__ float rsum_fin(const f32x4 a) {
    if (!PARTS) return a[0];
    const float q = (a[0] + a[1]) + (a[2] + a[3]);
    const auto r = __builtin_amdgcn_permlane16_swap(__float_as_uint(q), __float_as_uint(q), false, false); const float h = __uint_as_float(r[0]) + __uint_as_float(r[1]);
    const auto t = __builtin_amdgcn_permlane32_swap(__float_as_uint(h), __float_as_uint(h), false, false); return __uint_as_float(t[0]) + __uint_as_float(t[1]);
}
template <bool PARTS> struct EpiIn {
    static constexpr bool PERM = true, AFTER_DRAIN = false;
    const float* ss; bf16_t* ub; bf16_t* qd; const float* ropeC; const float* ropeD; size_t bstride;
    __device__ __forceinline__ void operator()(const f32x4 (&acc)[2][2][4][2], const Unit& u, int wr, int wc, int fr, int fq) const {
        asm volatile("" : "+v"(fr), "+v"(fq));
        const int pn = u.pn, row0 = u.pm * BM + wr * 64 + fr, cl = wc * 32 + 8 * fq;
        float rsv[2][4];
        { f32x4 rq[2][4];
#pragma unroll
          for (int ai = 0; ai < 2; ++ai)
#pragma unroll
              for (int m = 0; m < 4; ++m) rq[ai][m] = rsum_ld<PARTS>(ss, row0 + ai * HALF + m * 16, fq);
#pragma unroll
          for (int ai = 0; ai < 2; ++ai)
#pragma unroll
              for (int m = 0; m < 4; ++m) rsv[ai][m] = __builtin_amdgcn_rsqf(rsum_fin<PARTS>(rq[ai][m]) * (1.0f / 1024.0f) + RMS_EPS); }
        if (pn < 2) {
            bf16_t* Z = ub + (size_t)pn * HALF + cl;
#pragma unroll
            for (int ai = 0; ai < 2; ++ai)
#pragma unroll
                for (int m = 0; m < 4; ++m) { const int row = row0 + ai * HALF + m * 16; const float rs = rsv[ai][m];
                    f32x4 z0, z1;
                    { const float rsn = rs * -1.4426950408889634f; f32x4 e0 = acc[ai][1][m][0] * rsn, e1 = acc[ai][1][m][1] * rsn;
#pragma unroll
                      for (int j = 0; j < 4; ++j) { e0[j] = __builtin_amdgcn_exp2f(e0[j]); e1[j] = __builtin_amdgcn_exp2f(e1[j]); }
                      e0 = e0 + 1.0f; e1 = e1 + 1.0f;
#pragma unroll
                      for (int j = 0; j < 4; ++j) { e0[j] = __builtin_amdgcn_rcpf(e0[j]); e1[j] = __builtin_amdgcn_rcpf(e1[j]); }
                      z0 = (acc[ai][0][m][0] * rs) * e0; z1 = (acc[ai][0][m][1] * rs) * e1; }
                    *(u32x4*)(Z + (size_t)row * 256) = pack8(z0, z1); asm volatile("" ::: "memory"); }
        } else if (pn == 2 || pn == 5 || pn == 8) {
            bf16_t* O = ub + (size_t)(pn == 2 ? 1 : (pn == 5 ? 4 : 6)) * bstride + cl;
#pragma unroll
            for (int ai = 0; ai < 2; ++ai)
#pragma unroll
                for (int m = 0; m < 4; ++m) { const int row = row0 + ai * HALF + m * 16; const float rs = rsv[ai][m];
#pragma unroll
                    for (int bj = 0; bj < 2; ++bj) *(u32x4*)(O + (size_t)row * 256 + bj * HALF) = pack8(acc[ai][bj][m][0] * rs, acc[ai][bj][m][1] * rs);
                    asm volatile("" ::: "memory"); }
        } else if (pn < 5) {
            bf16_t* O = ub + (size_t)(pn - 1) * bstride + cl; const float sc = (pn == 3) ? SCALE_C : 1.0f;
            const bool rotw = (wc & 1) == 0; const bool rotl = fq < 2;
#pragma unroll
            for (int ai = 0; ai < 2; ++ai)
#pragma unroll
                for (int m = 0; m < 4; ++m) { const int row = row0 + ai * HALF + m * 16; const float rs = rsv[ai][m];
                    f32x4 cs = (f32x4){1.f, 1.f, 1.f, 1.f}, sn = (f32x4){0.f, 0.f, 0.f, 0.f};
                    if (rotw) { const float* tp = ropeC + (size_t)(row & 4095) * 16 + (fq & 1) * 8; const f32x4 c4 = *(const f32x4*)tp, s4 = *(const f32x4*)(tp + 4); if (rotl) { cs = c4; sn = s4; } }
#pragma unroll
                    for (int bj = 0; bj < 2; ++bj) { const f32x4 x1 = acc[ai][bj][m][0] * rs, x2 = acc[ai][bj][m][1] * rs;
                        *(u32x4*)(O + (size_t)row * 256 + bj * HALF) = pack8((x1 * cs - x2 * sn) * sc, (x2 * cs + x1 * sn) * sc); }
                    asm volatile("" ::: "memory"); }
        } else {
            const bool rotl = fq == 0;
#pragma unroll
            for (int ai = 0; ai < 2; ++ai)
#pragma unroll
                for (int m = 0; m < 4; ++m) { const int row = row0 + ai * HALF + m * 16; const float rs = rsv[ai][m];
                    f32x4 cs = (f32x4){1.f, 1.f, 1.f, 1.f}, sn = (f32x4){0.f, 0.f, 0.f, 0.f};
                    { const float* tp = ropeD + (size_t)(row & 4095) * 8; const f32x4 c4 = *(const f32x4*)tp, s4 = *(const f32x4*)(tp + 4); if (rotl) { cs = c4; sn = s4; } }
#pragma unroll
                    for (int bj = 0; bj < 2; ++bj) { const f32x4 x1 = acc[ai][bj][m][0] * rs, x2 = acc[ai][bj][m][1] * rs;
                        const f32x4 o1 = x1 * cs - x2 * sn, o2 = x2 * cs + x1 * sn;
                        if (pn == 6) { const int comp = 4 * bj + wc, which = comp & 1; bf16_t* q = qd + (size_t)row * 512 + comp * 64 + 8 * fq;
                            *(u32x4*)(q + which * 32) = pack8(o1 * SCALE_D, o2 * SCALE_D); *(u32x4*)(q + (1 - which) * 32) = (u32x4){0u, 0u, 0u, 0u}; }
                        else *(u32x4*)(ub + 5 * bstride + (size_t)row * 256 + bj * HALF + cl) = pack8(o1, o2); }
                    asm volatile("" ::: "memory"); }
        }
    }
};
template <bool DO_SS, bool F8, bool XF32> struct EpiRes {
    static constexpr bool PERM = true, AFTER_DRAIN = false;
    const float* xin; bf16_t* xb; unsigned char* xb8; float* ss; float ascale;
    __device__ __forceinline__ void operator()(const f32x4 (&acc)[2][2][4][2], const Unit& u, int wr, int wc, int fr, int fq) const {
        asm volatile("" : "+v"(fr), "+v"(fq));
        const int row0 = u.pm * BM + wr * 64 + fr, col0 = u.pn * BM + wc * 32 + 8 * fq;
#pragma unroll
        for (int ai = 0; ai < 2; ++ai) {
            f32x4 res[4][2][2];
#pragma unroll
            for (int m = 0; m < 4; ++m) { const size_t off = (size_t)(row0 + ai * HALF + m * 16) * 1024 + col0;
#pragma unroll
                for (int bj = 0; bj < 2; ++bj) { const size_t o = off + bj * HALF;
                    if (XF32) { res[m][bj][0] = __builtin_nontemporal_load((const f32x4*)(xin + o)); res[m][bj][1] = __builtin_nontemporal_load((const f32x4*)(xin + o + 4)); }
                    else { const u32x4 w = *(const u32x4*)(xb + o);
                        res[m][bj][0] = (f32x4){__uint_as_float(w.x << 16), __uint_as_float(w.x & 0xffff0000u), __uint_as_float(w.y << 16), __uint_as_float(w.y & 0xffff0000u)};
                        res[m][bj][1] = (f32x4){__uint_as_float(w.z << 16), __uint_as_float(w.z & 0xffff0000u), __uint_as_float(w.w << 16), __uint_as_float(w.w & 0xffff0000u)}; } } }
            u32x2 w8[2][2];
#pragma unroll
            for (int m = 0; m < 4; ++m) { const int row = row0 + ai * HALF + m * 16; const size_t off = (size_t)row * 1024 + col0; float part = 0.f;
#pragma unroll
                for (int bj = 0; bj < 2; ++bj) { const size_t o = off + bj * HALF;
                    const f32x4 v0 = res[m][bj][0] + acc[ai][bj][m][0] * ascale, v1 = res[m][bj][1] + acc[ai][bj][m][1] * ascale;
                    *(u32x4*)(xb + o) = pack8(v0, v1);
                    if (F8) { u32x2 w; w.x = pack4_fp8(v0[0] * F8_ACT, v0[1] * F8_ACT, v0[2] * F8_ACT, v0[3] * F8_ACT); w.y = pack4_fp8(v1[0] * F8_ACT, v1[1] * F8_ACT, v1[2] * F8_ACT, v1[3] * F8_ACT); w8[m & 1][bj] = w;
                        if (m & 1) st16_rowpair(w8[0][bj], w8[1][bj], xb8 + o - (size_t)(16 - 16 * (fq & 1)) * 1024 - 8 * (fq & 1)); }
                    const f32x4 q = v0 * v0 + v1 * v1; part += (q[0] + q[1]) + (q[2] + q[3]); }
                if (DO_SS) { part += __shfl_xor(part, 16); part += __shfl_xor(part, 32);
                    if (fq == 0) ss[(size_t)row * 16 + u.pn * 4 + wc] = part; } }
            asm volatile("" ::: "memory"); }
    }
};
template <bool PARTS, bool F8> struct EpiGlu {
    static constexpr bool PERM = true, AFTER_DRAIN = false;
    void* Hv; int ldh; const float* ss; int o_off;
    __device__ __forceinline__ void operator()(const f32x4 (&acc)[2][2][4][2], const Unit& u, int wr, int wc, int fr, int fq) const {
        asm volatile("" : "+v"(fr), "+v"(fq));
        const int row0 = u.pm * BM + wr * 64 + fr; const size_t c0 = (size_t)u.pn * HALF + wc * 32 + 8 * fq;
        float rs8[2][4];
        if (!PARTS) {
#pragma unroll
            for (int ai = 0; ai < 2; ++ai)
#pragma unroll
                for (int m = 0; m < 4; ++m) rs8[ai][m] = ss[row0 + ai * HALF + m * 16]; }
#pragma unroll
        for (int ai = 0; ai < 2; ++ai) {
            float rsv[4]; f32x4 rq[4]; u32x2 w8[4];
#pragma unroll
            for (int m = 0; m < 4; ++m) rq[m] = PARTS ? rsum_ld<PARTS>(ss, row0 + ai * HALF + m * 16, fq) : (f32x4){rs8[ai][m], 0.f, 0.f, 0.f};
#pragma unroll
            for (int m = 0; m < 4; ++m) rsv[m] = __builtin_amdgcn_rsqf((PARTS ? rsum_fin<PARTS>(rq[m]) : rq[m][0]) * (1.0f / 1024.0f) + RMS_EPS) * (F8 ? F8_INV : 1.0f);
#pragma unroll
            for (int m = 0; m < 4; ++m) { const int row = row0 + ai * HALF + m * 16; const float rs = rsv[m];
                f32x4 z0, z1;
                { const float rsn = rs * -1.4426950408889634f, rsu = rs * (F8 ? F8_ACT : 1.0f);
                  const f32x4 g0 = acc[ai][0][m][0] * rs, g1 = acc[ai][0][m][1] * rs, t0 = acc[ai][0][m][0] * rsn, t1 = acc[ai][0][m][1] * rsn, u0 = acc[ai][1][m][0] * rsu, u1 = acc[ai][1][m][1] * rsu;
                  f32x4 e0, e1;
#pragma unroll
                  for (int j = 0; j < 4; ++j) { e0[j] = __builtin_amdgcn_exp2f(t0[j]); e1[j] = __builtin_amdgcn_exp2f(t1[j]); }
                  e0 = e0 + 1.0f; e1 = e1 + 1.0f;
#pragma unroll
                  for (int j = 0; j < 4; ++j) { e0[j] = __builtin_amdgcn_rcpf(e0[j]); e1[j] = __builtin_amdgcn_rcpf(e1[j]); }
                  z0 = (g0 * e0) * u0; z1 = (g1 * e1) * u1; }
                const size_t o = (size_t)(row - o_off * BM) * ldh + c0;
                if (F8) { w8[m].x = pack4_fp8(z0[0], z0[1], z0[2], z0[3]); w8[m].y = pack4_fp8(z1[0], z1[1], z1[2], z1[3]);
                    if (m & 1) st16_rowpair(w8[(m - 1) & 3], w8[m], (unsigned char*)Hv + (size_t)(row - 16 + 16 * (fq & 1) - o_off * BM) * ldh + (c0 - 8 * (fq & 1))); }
                else *(u32x4*)((bf16_t*)Hv + o) = pack8(z0, z1);
                asm volatile("" ::: "memory"); } }
    }
};
struct EpiY {
    static constexpr bool PERM = true, AFTER_DRAIN = false;
    unsigned char* Y;
    __device__ __forceinline__ void operator()(const f32x4 (&acc)[2][2][4][2], const Unit& u, int wr, int wc, int fr, int fq) const {
        asm volatile("" : "+v"(fr), "+v"(fq));
        const int row0 = u.pm * BM + wr * 64 + fr; unsigned char* O = Y + (size_t)u.pn * BM + wc * 32 + 8 * fq; constexpr float s = F8_INV * Y_SCALE;
#pragma unroll
        for (int ai = 0; ai < 2; ++ai)
#pragma unroll
            for (int m = 0; m < 4; m += 2) { const int row = row0 + ai * HALF + m * 16 + 16 * (fq & 1);
#pragma unroll
                for (int bj = 0; bj < 2; ++bj) { u32x2 w[2];
#pragma unroll
                    for (int t = 0; t < 2; ++t) { const f32x4 v0 = acc[ai][bj][m + t][0] * s, v1 = acc[ai][bj][m + t][1] * s; w[t].x = pack4_fp8(v0[0], v0[1], v0[2], v0[3]); w[t].y = pack4_fp8(v1[0], v1[1], v1[2], v1[3]); }
                    st16_rowpair(w[0], w[1], O + (size_t)row * 1024 + bj * HALF - 8 * (fq & 1)); } }
    }
};
#ifndef F8_SCALE
#define F8_SCALE 0x7F7F7F7F
#endif
typedef int v4i32 __attribute__((ext_vector_type(4))); typedef int v8i32 __attribute__((ext_vector_type(8)));
__device__ __forceinline__ v8i32 cat8(const bf16x8 lo, const bf16x8 hi) { return __builtin_shufflevector(__builtin_bit_cast(v4i32, lo), __builtin_bit_cast(v4i32, hi), 0, 1, 2, 3, 4, 5, 6, 7); }
template <class Epi, class Sched, bool ALIGN_EPI = false, bool SP2 = false, bool F8 = false>
__device__ __forceinline__ void gemm_phase(PG8_LAS unsigned char* lds, const Gemm g, const Sched& S, const Epi& E) {
    int tid_ = threadIdx.x; asm volatile("" : "+v"(tid_));
    const int tid = tid_, wid = __builtin_amdgcn_readfirstlane(tid >> 6), lane = tid & 63, wr = wid >> 2, wc = wid & 3, fr = lane & 15, fq = lane >> 4;
    const int K = g.K, nt = K / BK;
    unsigned voffA[2], voffB[2];
#pragma unroll
    for (int i = 0; i < 2; ++i) { int R, C; stage_rc(tid * 16 + i * 8192, R, C); const int Rb = Epi::PERM ? ((R & ~31) + perm32(R & 31)) : R;
        voffA[i] = (unsigned)(R * K + C) * 2u; voffB[i] = (unsigned)(Rb * K + C) * 2u; }
    const size_t kstep = (size_t)(BK * 2);
    const size_t hstep = (size_t)HALF * K * 2;
    const unsigned ldsw = (unsigned)wid * 1024u;
    const int aoff = lds_byte(wr * 64 + fr, fq * 8), boff = lds_byte(wc * 32 + fr, fq * 8);
#define PG8_SA(b, h) (((b) * 2 + (h)) * HTB)
#define PG8_SB(b, h) ((4 + (b) * 2 + (h)) * HTB)
#define PG8_STAGE(bufoff, gbase, voff) do { _Pragma("unroll") for (int _i = 0; _i < 2; ++_i) \
        __builtin_amdgcn_global_load_lds((const unsigned*)((const char*)(gbase) + (voff)[_i]), (PG8_LAS unsigned*)(lds + (bufoff) + ldsw + _i * 8192), 16, 0, 0); } while (0)
#define PG8_LDA(dst, b, h) do { _Pragma("unroll") for (int m = 0; m < 4; ++m) _Pragma("unroll") for (int k = 0; k < 2; ++k) dst[m][k] = *(const PG8_LAS bf16x8*)(lds + PG8_SA(b, h) + aoff + m * 2048 + k * 1024); } while (0)
#define PG8_LDB(dst, b, h) do { _Pragma("unroll") for (int n = 0; n < 2; ++n) _Pragma("unroll") for (int k = 0; k < 2; ++k) dst[n][k] = *(const PG8_LAS bf16x8*)(lds + PG8_SB(b, h) + boff + n * 2048 + k * 1024); } while (0)
#define PG8_MMA(ai, bj, At, Bt) do { __builtin_amdgcn_s_setprio(1); _Pragma("unroll") for (int m = 0; m < 4; ++m) _Pragma("unroll") for (int n = 0; n < 2; ++n) { \
        if constexpr (F8) { const v8i32 b8_ = cat8(Bt[n][0], Bt[n][1]), a8_ = cat8(At[m][0], At[m][1]); \
            asm volatile("v_mfma_scale_f32_16x16x128_f8f6f4 %0, %1, %2, %0, %3, %3 op_sel_hi:[0,0,0]" : "+v"(acc[ai][bj][m][n]) : "v"(b8_), "v"(a8_), "v"(f8scale_)); }     \
        else { _Pragma("unroll") for (int k = 0; k < 2; ++k) acc[ai][bj][m][n] = __builtin_amdgcn_mfma_f32_16x16x32_bf16(Bt[n][k], At[m][k], acc[ai][bj][m][n], 0, 0, 0); } } __builtin_amdgcn_s_setprio(0); } while (0)
#define PG8_WAIT_V(n) asm volatile("s_waitcnt vmcnt(" #n ")" ::: "memory")
#define PG8_WAIT_L(n) asm volatile("s_waitcnt lgkmcnt(" #n ")" ::: "memory")
#define PG8_BAR __builtin_amdgcn_s_barrier()
#define PG8_SCHED __builtin_amdgcn_sched_barrier(0)
    int f8scale_ = F8_SCALE; asm volatile("" : "+v"(f8scale_));
    Unit cur, nxt; int ui = 0;
    if (!S.next(0, cur)) return;
    f32x4 acc[2][2][4][2];
#pragma unroll
    for (int a = 0; a < 2; ++a)
#pragma unroll
        for (int b = 0; b < 2; ++b)
#pragma unroll
            for (int m = 0; m < 4; ++m)
#pragma unroll
                for (int n = 0; n < 2; ++n) acc[a][b][m][n] = (f32x4){0.f, 0.f, 0.f, 0.f};
    bf16x8 At[4][2], B0[2][2], B1[2][2];
    const char* cA = S.a_ptr(g, cur); const char* cB = S.b_ptr(g, cur);
    S.a_ready(cur);
    if constexpr (SP2) {
        PG8_STAGE(PG8_SB(0, 0), cB, voffB); PG8_STAGE(PG8_SB(0, 1), cB + hstep, voffB); PG8_STAGE(PG8_SA(0, 0), cA, voffA); PG8_STAGE(PG8_SA(0, 1), cA + hstep, voffA);
        if (wr == 1) PG8_BAR;
        PG8_WAIT_V(2); PG8_BAR;
        PG8_STAGE(PG8_SB(1, 0), cB + kstep, voffB); PG8_STAGE(PG8_SA(1, 0), cA + kstep, voffA); PG8_STAGE(PG8_SB(1, 1), cB + hstep + kstep, voffB);
        PG8_WAIT_V(6); PG8_BAR;
    } else {
        PG8_STAGE(PG8_SB(0, 0), cB, voffB); PG8_STAGE(PG8_SA(0, 0), cA, voffA); PG8_STAGE(PG8_SB(0, 1), cB + hstep, voffB); PG8_STAGE(PG8_SA(0, 1), cA + hstep, voffA);
        if (wr == 1) PG8_BAR;
        PG8_WAIT_V(4); PG8_BAR;
        PG8_STAGE(PG8_SB(1, 0), cB + kstep, voffB); PG8_STAGE(PG8_SA(1, 0), cA + kstep, voffA); PG8_STAGE(PG8_SB(1, 1), cB + hstep + kstep, voffB);
        PG8_WAIT_V(6); PG8_BAR;
    }
    for (;;) {
        const bool has_next = S.next(ui + 1, nxt);
        const char* nA = has_next ? S.a_ptr(g, nxt) : cA; const char* nB = has_next ? S.b_ptr(g, nxt) : cB;
#pragma nounroll
        for (int t = 0; t < nt; t += 2) {
            const bool last = (t == nt - 2);
            const char* a1 = cA + (size_t)(t + 1) * kstep;
            const char* a2 = last ? nA : cA + (size_t)(t + 2) * kstep; const char* b2 = last ? nB : cB + (size_t)(t + 2) * kstep;
            const char* a3 = a2 + kstep; const char* b3 = b2 + kstep;
            if (last && has_next) S.a_ready(nxt);
            if constexpr (SP2) {
            PG8_LDB(B0, 0, 0); PG8_LDB(B1, 0, 1); PG8_SCHED; PG8_LDA(At, 0, 0); PG8_STAGE(PG8_SA(1, 1), a1 + hstep, voffA);
            PG8_WAIT_V(8); PG8_WAIT_L(0); PG8_BAR; PG8_MMA(0, 0, At, B0); PG8_MMA(0, 1, At, B1); PG8_BAR; PG8_SCHED;
            PG8_LDA(At, 0, 1); PG8_STAGE(PG8_SB(0, 0), b2, voffB); PG8_STAGE(PG8_SB(0, 1), b2 + hstep, voffB); PG8_STAGE(PG8_SA(0, 0), a2, voffA);
            PG8_WAIT_V(8); PG8_WAIT_L(0); PG8_BAR; PG8_MMA(1, 0, At, B0); PG8_MMA(1, 1, At, B1); PG8_BAR; PG8_SCHED;
            PG8_LDB(B0, 1, 0); PG8_LDB(B1, 1, 1); PG8_SCHED; PG8_LDA(At, 1, 0); PG8_STAGE(PG8_SA(0, 1), a2 + hstep, voffA);
            PG8_WAIT_V(8); PG8_WAIT_L(0); PG8_BAR; PG8_MMA(0, 0, At, B0); PG8_MMA(0, 1, At, B1); PG8_BAR; PG8_SCHED;
            PG8_LDA(At, 1, 1); PG8_STAGE(PG8_SB(1, 0), b3, voffB); PG8_STAGE(PG8_SB(1, 1), b3 + hstep, voffB); PG8_STAGE(PG8_SA(1, 0), a3, voffA);
            PG8_WAIT_V(8); PG8_WAIT_L(0); PG8_BAR; PG8_MMA(1, 0, At, B0); PG8_MMA(1, 1, At, B1); PG8_BAR; PG8_SCHED;
            } else {
            PG8_LDB(B0, 0, 0); PG8_SCHED; PG8_LDA(At, 0, 0); PG8_STAGE(PG8_SA(1, 1), a1 + hstep, voffA);
            PG8_WAIT_L(8); PG8_BAR; PG8_WAIT_L(0); PG8_MMA(0, 0, At, B0); PG8_BAR; PG8_SCHED;
            PG8_LDB(B1, 0, 1); PG8_STAGE(PG8_SB(0, 0), b2, voffB);
            PG8_BAR; PG8_WAIT_L(0); PG8_MMA(0, 1, At, B1); PG8_BAR;
            PG8_LDA(At, 0, 1); PG8_STAGE(PG8_SA(0, 0), a2, voffA);
            PG8_BAR; PG8_WAIT_L(0); PG8_MMA(1, 0, At, B0); PG8_BAR; PG8_SCHED;
            PG8_STAGE(PG8_SB(0, 1), b2 + hstep, voffB);
            PG8_WAIT_V(6); PG8_BAR; PG8_MMA(1, 1, At, B1); PG8_BAR;
            PG8_LDB(B0, 1, 0); PG8_SCHED; PG8_LDA(At, 1, 0); PG8_STAGE(PG8_SA(0, 1), a2 + hstep, voffA);
            PG8_WAIT_L(8); PG8_BAR; PG8_WAIT_L(0); PG8_MMA(0, 0, At, B0); PG8_BAR; PG8_SCHED;
            PG8_LDB(B1, 1, 1); PG8_STAGE(PG8_SB(1, 0), b3, voffB);
            PG8_BAR; PG8_WAIT_L(0); PG8_MMA(0, 1, At, B1); PG8_BAR;
            PG8_LDA(At, 1, 1); PG8_STAGE(PG8_SA(1, 0), a3, voffA);
            PG8_BAR; PG8_WAIT_L(0); PG8_MMA(1, 0, At, B0); PG8_BAR; PG8_SCHED;
            PG8_STAGE(PG8_SB(1, 1), b3 + hstep, voffB);
            PG8_WAIT_V(6); PG8_BAR; PG8_MMA(1, 1, At, B1); PG8_BAR;
            }
        }
        if constexpr (ALIGN_EPI) { if (wr == 0) PG8_BAR; }
        if constexpr (F8) {
#define PG8_PIN8(a, b) asm volatile("" : "+v"(acc[a][b][0][0]), "+v"(acc[a][b][0][1]), "+v"(acc[a][b][1][0]), "+v"(acc[a][b][1][1]), "+v"(acc[a][b][2][0]), "+v"(acc[a][b][2][1]), "+v"(acc[a][b][3][0]), "+v"(acc[a][b][3][1]))
            asm volatile("s_nop 15\n\ts_nop 15" ::: "memory"); PG8_PIN8(0, 0); PG8_PIN8(0, 1); PG8_PIN8(1, 0); PG8_PIN8(1, 1);
#undef PG8_PIN8
        }
        if constexpr (!Epi::AFTER_DRAIN) { E(acc, cur, wr, wc, fr, fq);
#if defined(PG8_EPI_TWICE)
            if constexpr (Epi::PERM) { asm volatile("" ::: "memory"); E(acc, cur, wr, wc, fr, fq); }
#endif
            S.done(cur); }
        if (!has_next) break;
#pragma unroll
        for (int a = 0; a < 2; ++a)
#pragma unroll
            for (int b = 0; b < 2; ++b)
#pragma unroll
                for (int m = 0; m < 4; ++m)
#pragma unroll
                    for (int n = 0; n < 2; ++n) acc[a][b][m][n] = (f32x4){0.f, 0.f, 0.f, 0.f};
        cur = nxt; cA = nA; cB = nB; ++ui;
        if constexpr (ALIGN_EPI) { if (wr == 1) PG8_BAR; }
    }
    PG8_WAIT_V(0);
    if constexpr (!ALIGN_EPI) { if (wr == 0) PG8_BAR; }
    PG8_BAR;
    if constexpr (Epi::AFTER_DRAIN) { E.fused(acc, cur, wr, wc, fr, fq, lds, wid, lane); S.done(cur); }
#undef PG8_SA
#undef PG8_SB
#undef PG8_STAGE
#undef PG8_LDA
#undef PG8_LDB
#undef PG8_MMA
#undef PG8_WAIT_V
#undef PG8_WAIT_L
#undef PG8_BAR
#undef PG8_SCHED
}
}
namespace attn_body {
using bf16=__hip_bfloat16;
using bf16x8=__attribute__((ext_vector_type(8)))short;
using s16x4=__attribute__((ext_vector_type(4)))short;
using f32x16=__attribute__((ext_vector_type(16)))float;
using u32x4=__attribute__((ext_vector_type(4)))unsigned;
constexpr int SEQ=4096,D=64,QP=512,KP=256;
constexpr int NW=8,QBLK=32,QB=QBLK*NW,KVBLK=64,NQB=SEQ/QB;
constexpr int ATTN_UNIT_ROWS=QB;
__device__ __forceinline__ int crow(int r,int hi){return (r&3)+8*(r>>2)+4*hi;}
#define SBAR() __builtin_amdgcn_sched_barrier(0)
__device__ __forceinline__ void cmask(f32x16&p0,f32x16&p1,int jb,int qrel,int hi){
  const float NEG=-INFINITY; int kb=64*jb+4*hi;
  #pragma unroll
  for(int r=0;r<16;++r){int kv=kb+(r&3)+8*(r>>2); if(kv>qrel)p0[r]=NEG; if(kv+32>qrel)p1[r]=NEG;}
}

constexpr int NSLOT=3, SLOTB=8192;
constexpr int LDS_K=0, LDS_V=NSLOT*SLOTB, LDS_WS=2*NSLOT*SLOTB, LDS_OST=LDS_WS+NW*64*4, LDS_OA=LDS_OST+NW*4096, LDS_BYTES=LDS_OA+NW*4096;
constexpr float C2=0.125f*1.4426950408889634f;
__device__ __forceinline__ void glds16(const void*gsrc,unsigned lds_dst){unsigned keep;
  asm volatile("s_mov_b32 %0, m0\n\ts_mov_b32 m0, %2\n\ts_nop 0\n\tglobal_load_lds_dwordx4 %1, off\n\ts_mov_b32 m0, %0":"=&s"(keep):"v"(gsrc),"s"(lds_dst):"memory");}
__device__ __forceinline__ float max3f(float a,float b,float c){float r;asm("v_max3_f32 %0, %1, %2, %3":"=v"(r):"v"(a),"v"(b),"v"(c));return r;}
__device__ __forceinline__ float max2f(float a,float b){float r;asm("v_max_f32_e32 %0, %1, %2":"=v"(r):"v"(a),"v"(b));return r;}
__device__ __forceinline__ float fadd_s(float a,float b){float r;asm("v_add_f32_e32 %0, %1, %2":"=v"(r):"v"(a),"v"(b));return r;}
__device__ __forceinline__ float fsub_s(float a,float b){float r;asm("v_sub_f32_e32 %0, %1, %2":"=v"(r):"v"(a),"v"(b));return r;}
typedef float f32x2_t __attribute__((ext_vector_type(2))); typedef __bf16 bf16x2_t __attribute__((ext_vector_type(2)));
__device__ __forceinline__ unsigned cvtpk_s(float lo,float hi){f32x2_t v={lo,hi};bf16x2_t b=__builtin_convertvector(v,bf16x2_t);return __builtin_bit_cast(unsigned,b);}
#define WAIT_BAR(N) asm volatile("s_waitcnt vmcnt(" #N ") lgkmcnt(0)\n\ts_barrier":::"memory")

template<int D0A,int D0B> __device__ __forceinline__ void qkt(f32x16&p0,f32x16&p1,const char*Kslot,const bf16x8*qr,const f32x16&negm,int r32,int hi){
  const char*kb=Kslot+hi*1024+r32*16;
  #pragma unroll
  for(int d0=D0A;d0<D0B;++d0){
    const bf16x8 b0=*reinterpret_cast<const bf16x8*>(kb+d0*2048);
    const bf16x8 b1=*reinterpret_cast<const bf16x8*>(kb+d0*2048+512);
    if(d0==D0A){p0=__builtin_amdgcn_mfma_f32_32x32x16_bf16(b0,qr[d0],negm,0,0,0);p1=__builtin_amdgcn_mfma_f32_32x32x16_bf16(b1,qr[d0],negm,0,0,0);}
    else{p0=__builtin_amdgcn_mfma_f32_32x32x16_bf16(b0,qr[d0],p0,0,0,0);p1=__builtin_amdgcn_mfma_f32_32x32x16_bf16(b1,qr[d0],p1,0,0,0);}}
}
typedef __attribute__((address_space(3))) const char* lds_cptr;
typedef short v4i16_t __attribute__((ext_vector_type(4)));
__device__ __forceinline__ void kload8(bf16x8*kf,lds_cptr kp){
  kf[0]=*(const __attribute__((address_space(3))) bf16x8*)(kp);      kf[1]=*(const __attribute__((address_space(3))) bf16x8*)(kp+512);
  kf[2]=*(const __attribute__((address_space(3))) bf16x8*)(kp+2048); kf[3]=*(const __attribute__((address_space(3))) bf16x8*)(kp+2560);
  kf[4]=*(const __attribute__((address_space(3))) bf16x8*)(kp+4096); kf[5]=*(const __attribute__((address_space(3))) bf16x8*)(kp+4608);
  kf[6]=*(const __attribute__((address_space(3))) bf16x8*)(kp+6144); kf[7]=*(const __attribute__((address_space(3))) bf16x8*)(kp+6656);
}
__device__ __forceinline__ void kload2(bf16x8*kf,lds_cptr kp,int j){ kf[2*j]=*(const __attribute__((address_space(3))) bf16x8*)(kp+j*2048); kf[2*j+1]=*(const __attribute__((address_space(3))) bf16x8*)(kp+j*2048+512); }
__device__ __forceinline__ s16x4 vtr(lds_cptr p){ return __builtin_bit_cast(s16x4,__builtin_amdgcn_ds_read_tr16_b64_v4i16((__attribute__((address_space(3))) v4i16_t*)p)); }
__device__ __forceinline__ float rowmax(const f32x16&p0,const f32x16&p1){
  float a=max3f(p0[0],p0[1],p1[0]),b=max3f(p0[2],p0[3],p1[1]);a=max3f(a,p1[2],p1[3]);
  #pragma unroll
  for(int r=4;r<16;r+=4){a=max3f(a,p0[r],p0[r+1]);b=max3f(b,p0[r+2],p0[r+3]);a=max3f(a,p1[r],p1[r+1]);b=max3f(b,p1[r+2],p1[r+3]);}
  const float m=max2f(a,b);
  auto rr=__builtin_amdgcn_permlane32_swap(__float_as_uint(m),__float_as_uint(m),false,false);
  return max2f(__uint_as_float(rr[0]),__uint_as_float(rr[1]));
}
__device__ __forceinline__ void pv(f32x16*o,int vb,bf16x8 pa0,bf16x8 pa1,bf16x8 pa2,bf16x8 pa3){
  #pragma unroll
  for(int d0=0;d0<2;++d0){s16x4 lo[4],hi[4];
    #pragma unroll
    for(int ks=0;ks<4;++ks){
      asm volatile("ds_read_b64_tr_b16 %0,%1 offset:%c2":"=&v"(lo[ks]):"v"(vb),"i"(d0*4096+ks*1024):"memory");
      asm volatile("ds_read_b64_tr_b16 %0,%1 offset:%c2":"=&v"(hi[ks]):"v"(vb),"i"(d0*4096+ks*1024+512):"memory");}
    asm volatile("s_waitcnt lgkmcnt(0)":::"memory");SBAR();
    #define PK(k) (bf16x8){lo[k][0],lo[k][1],lo[k][2],lo[k][3],hi[k][0],hi[k][1],hi[k][2],hi[k][3]}
    o[d0]=__builtin_amdgcn_mfma_f32_32x32x16_bf16(pa0,PK(0),o[d0],0,0,0);
    o[d0]=__builtin_amdgcn_mfma_f32_32x32x16_bf16(pa1,PK(1),o[d0],0,0,0);
    o[d0]=__builtin_amdgcn_mfma_f32_32x32x16_bf16(pa2,PK(2),o[d0],0,0,0);
    o[d0]=__builtin_amdgcn_mfma_f32_32x32x16_bf16(pa3,PK(3),o[d0],0,0,0);
    #undef PK
  }
}

#ifndef ATTN_STORE16
#define ATTN_STORE16(p,v) (*(u32x4*)(p)=(v))
#endif
template<int THRL,int MODE> __device__ __forceinline__ void attn_unit(int b,int h,int qb,const bf16*Q,const bf16*__restrict__ K,const bf16*__restrict__ V,bf16*O,char*shm,float lam=0.f,float omli=0.f,const float*dg=nullptr){
  constexpr int D0A=(MODE==2)?2:0, D0B=(MODE==1)?2:4;
  int tid_=threadIdx.x; asm volatile("":"+v"(tid_));
  const int tid=tid_,lane=tid&63,r32=lane&31,hi=lane>>5; const int wid=__builtin_amdgcn_readfirstlane(tid>>6);
  const long rowbase=(long)b*SEQ; const int q0=qb*QB;
  const bf16*Qw=Q+(rowbase+q0+wid*QBLK)*QP+h*D;
  const bf16*Kh=K+rowbase*KP+(h>>1)*D,*Vh=V+rowbase*KP+(h>>1)*D;
  const unsigned lds0=(unsigned)(uintptr_t)shm;
  float*wsf=(float*)(shm+LDS_WS)+wid*64;
  const bf16*ksrc=Kh+(long)lane*KP+wid*8;
  const bf16*vsrc=Vh+(long)(16*(wid&3)+(lane>>2))*KP+(wid>>2)*32+(lane&3)*8;
  const unsigned kdst=lds0+LDS_K+wid*1024, vdst=lds0+LDS_V+wid*1024;
  #define DMA_K(t,slot) glds16(ksrc+(long)(t)*KVBLK*KP,(unsigned)__builtin_amdgcn_readfirstlane(kdst+(slot)))
  #define DMA_V(t,slot) glds16(vsrc+(long)(t)*KVBLK*KP,(unsigned)__builtin_amdgcn_readfirstlane(vdst+(slot)))
  const int vb0=(int)(lds0+LDS_V)+((lane>>4)&1)*32+(lane&3)*8+(4*hi+((lane&15)>>2))*64;
  const char*Kbase=shm+LDS_K; bf16x8 kf[8];
  const lds_cptr shm3=(lds_cptr)shm; const lds_cptr kp0=shm3+LDS_K+hi*1024+r32*16; const lds_cptr vp0=shm3+LDS_V+((lane>>4)&1)*32+(lane&3)*8+(4*hi+((lane&15)>>2))*64;
  const int NT=(q0+QB)/KVBLK;
  DMA_K(0,0);DMA_V(0,0);DMA_K(1,SLOTB);
  bf16x8 qr[4];
  #pragma unroll
  for(int d0=D0A;d0<D0B;++d0)qr[d0]=*reinterpret_cast<const bf16x8*>(&Qw[(long)r32*QP+d0*16+hi*8]);
  float mhat=0.f,l_reg=0.f;f32x16 o[2];o[0]=f32x16{};o[1]=f32x16{};f32x16 negm=f32x16{};asm volatile("":"+v"(negm));
  const int qrel=wid*QBLK+r32;
  #define CMASK(P0,P1,t) do{int jb_=(t)-(NT-4); if(jb_>=0)cmask(P0,P1,jb_,qrel,hi);}while(0)
  bool resc=false;
  #define START(P0,P1) do{ const float rm=rowmax(P0,P1); resc=false; \
    { const float dl=rm; mhat=fadd_s(mhat,dl); \
      _Pragma("unroll") for(int r=0;r<16;++r){P0[r]=fsub_s(P0[r],dl);P1[r]=fsub_s(P1[r],dl);} \
      _Pragma("unroll") for(int r=0;r<16;++r)negm[r]=-mhat; asm volatile("":"+v"(negm)); } \
    _Pragma("unroll") for(int r=0;r<16;++r)P0[r]=__builtin_amdgcn_exp2f(P0[r]); }while(0)
  #define RESC() do{ if(resc){ asm volatile("s_waitcnt lgkmcnt(0)":::"memory"); \
      _Pragma("unroll") for(int d_=0;d_<2;++d_) _Pragma("unroll") for(int r=0;r<16;++r)o[d_][r]*=wsf[crow(r,hi)]; } }while(0)
  f32x16 pA0,pA1,pB0,pB1;
  int sl_prev=0,sl_cur=0,sl_next=SLOTB;
  #define ROT() do{sl_prev=sl_cur;sl_cur=sl_next;sl_next=(sl_next==(NSLOT-1)*SLOTB)?0:sl_next+SLOTB;}while(0)
  DMA_K(2,2*SLOTB);
  WAIT_BAR(3);
  qkt<D0A,D0B>(pA0,pA1,Kbase,qr,negm,r32,hi);asm volatile("s_nop 15\n\ts_nop 7":"+v"(pA0),"+v"(pA1));CMASK(pA0,pA1,0);
  START(pA0,pA1);
  _Pragma("unroll") for(int r=0;r<16;++r)pA1[r]=__builtin_amdgcn_exp2f(pA1[r]);
  WAIT_BAR(0);
  DMA_K(3,0);DMA_V(1,SLOTB);
  ROT();
  _Pragma("unroll") for(int j_=D0A;j_<D0B;++j_)kload2(kf,kp0+sl_cur,j_);
  WAIT_BAR(2);
  s16x4 vlo[8],vhi[8]; u32x4 pw0,pw1,pw2,pw3;
  #define PKW(P,B) cvtpk_s(P[B],P[B+1])
  #define PAF(k) __builtin_bit_cast(bf16x8,pw##k)
  #define VFR(i) (bf16x8){vlo[i][0],vlo[i][1],vlo[i][2],vlo[i][3],vhi[i][0],vhi[i][1],vhi[i][2],vhi[i][3]}
  #define PIN(x) asm volatile("":"+v"(x))
  #define MX3(a,b,c) __builtin_fmaxf(__builtin_fmaxf((a),(b)),(c))
  #define QKM(s,C) do{ if constexpr(((s)>>1)>=D0A&&((s)>>1)<D0B){ if constexpr(((s)>>1)==D0A) C=__builtin_amdgcn_mfma_f32_32x32x16_bf16(kf[s],qr[(s)>>1],negm,0,0,0); else C=__builtin_amdgcn_mfma_f32_32x32x16_bf16(kf[s],qr[(s)>>1],C,0,0,0); } }while(0)
  #define GAPA(MF,A0,A1,A2,A3,W0,W1,PW) do{ MF; sacc+=A0; sacc+=A1; sacc+=A2; sacc+=A3; PIN(sacc); W0; W1; PIN(PW); SBAR(); }while(0)
  #define EX(v) __builtin_amdgcn_exp2f(v)
  #define GAPB(MF,X,B) do{ MF; X[B]=EX(X[B]); X[B+1]=EX(X[B+1]); X[B+2]=EX(X[B+2]); X[B+3]=EX(X[B+3]); PIN(X); SBAR(); }while(0)
  #define VRD(i) do{ vlo[i]=vtr(vp_+(((i)>>2)*4096+((i)&3)*1024)); vhi[i]=vtr(vp_+(((i)>>2)*4096+((i)&3)*1024+512)); }while(0)
  #define KRD(G,j) do{ if constexpr((j)>=D0A&&(j)<D0B){ if(G){ kload2(kf,kp0+sl_next,j); SBAR(); } } }while(0)
  #define STEP(C0,C1,P0,P1,t,GK,GV,GL) do{ SBAR(); \
    const lds_cptr vp_=vp0+sl_prev; \
    VRD(0); SBAR(); float sacc=(P0[0]+P0[1]); \
    GAPA(QKM(0,C0), P0[2],P0[3],P0[4],P0[5],     pw0[0]=PKW(P0,0), pw0[1]=PKW(P0,2), pw0); \
    VRD(4); SBAR(); GAPA(QKM(1,C1), P0[6],P0[7],P0[8],P0[9],     pw0[2]=PKW(P0,4), pw0[3]=PKW(P0,6), pw0); \
    VRD(1); SBAR(); GAPA(QKM(2,C0),   P0[10],P0[11],P0[12],P0[13], pw1[0]=PKW(P0,8), pw1[1]=PKW(P0,10), pw1); \
    VRD(5); SBAR(); GAPA(QKM(3,C1),   P0[14],P0[15],P1[0],P1[1],   pw1[2]=PKW(P0,12),pw1[3]=PKW(P0,14), pw1); \
    VRD(2); SBAR(); GAPA(QKM(4,C0),   P1[2],P1[3],P1[4],P1[5],     pw2[0]=PKW(P1,0), pw2[1]=PKW(P1,2), pw2); \
    VRD(6); SBAR(); GAPA(QKM(5,C1),   P1[6],P1[7],P1[8],P1[9],     pw2[2]=PKW(P1,4), pw2[3]=PKW(P1,6), pw2); \
    VRD(3); SBAR(); GAPA(QKM(6,C0),   P1[10],P1[11],P1[12],P1[13], pw3[0]=PKW(P1,8), pw3[1]=PKW(P1,10), pw3); \
    VRD(7); SBAR(); GAPA(QKM(7,C1),   P1[14],P1[15],0.f,0.f,       pw3[2]=PKW(P1,12),pw3[3]=PKW(P1,14), pw3); \
    l_reg+=sacc; \
    if(GK){DMA_K((t)+3,sl_cur);} if(GV){DMA_V((t)+1,sl_next);} \
    CMASK(C0,C1,t); \
    { float a=MX3(C0[0],C0[1],C1[0]),b=MX3(C0[2],C0[3],C1[1]); a=MX3(a,C1[2],C1[3]); \
      _Pragma("unroll") for(int r=4;r<16;r+=4){a=MX3(a,C0[r],C0[r+1]);b=MX3(b,C0[r+2],C0[r+3]);a=MX3(a,C1[r],C1[r+1]);b=MX3(b,C1[r+2],C1[r+3]);} \
      float rm=__builtin_fmaxf(a,b); { auto rr=__builtin_amdgcn_permlane32_swap(__float_as_uint(rm),__float_as_uint(rm),false,false); rm=__builtin_fmaxf(__uint_as_float(rr[0]),__uint_as_float(rr[1])); } \
      resc=false; \
      if(__builtin_expect(__any(rm>(float)THRL),0)){ const float dl=__builtin_fmaxf(rm,0.f); mhat+=dl; \
        _Pragma("unroll") for(int r=0;r<16;++r){C0[r]-=dl;C1[r]-=dl;} \
        _Pragma("unroll") for(int r=0;r<16;++r)negm[r]=-mhat; asm volatile("":"+v"(negm)); \
        const float f=__builtin_amdgcn_exp2f(-dl); l_reg*=f; if(hi==0)wsf[r32]=f; resc=true; } } \
    SBAR(); \
    GAPB(o[0]=__builtin_amdgcn_mfma_f32_32x32x16_bf16(PAF(0),VFR(0),o[0],0,0,0), C0,0); \
    GAPB(o[1]=__builtin_amdgcn_mfma_f32_32x32x16_bf16(PAF(0),VFR(4),o[1],0,0,0), C0,4); \
    KRD(GL,0); GAPB(o[0]=__builtin_amdgcn_mfma_f32_32x32x16_bf16(PAF(1),VFR(1),o[0],0,0,0), C0,8); \
    KRD(GL,1); GAPB(o[1]=__builtin_amdgcn_mfma_f32_32x32x16_bf16(PAF(1),VFR(5),o[1],0,0,0), C0,12); \
    KRD(GL,2); GAPB(o[0]=__builtin_amdgcn_mfma_f32_32x32x16_bf16(PAF(2),VFR(2),o[0],0,0,0), C1,0); \
    KRD(GL,3); GAPB(o[1]=__builtin_amdgcn_mfma_f32_32x32x16_bf16(PAF(2),VFR(6),o[1],0,0,0), C1,4); \
    GAPB(o[0]=__builtin_amdgcn_mfma_f32_32x32x16_bf16(PAF(3),VFR(3),o[0],0,0,0), C1,8); \
    GAPB(o[1]=__builtin_amdgcn_mfma_f32_32x32x16_bf16(PAF(3),VFR(7),o[1],0,0,0), C1,12); \
    }while(0)
  int t=1;
  #undef CMASK
  #define CMASK(P0,P1,t) do{}while(0)
  for(;t+5<NT;t+=2){
    STEP(pB0,pB1,pA0,pA1,t,true,true,true);     WAIT_BAR(2); RESC(); ROT();
    STEP(pA0,pA1,pB0,pB1,t+1,true,true,true);   WAIT_BAR(2); RESC(); ROT();
  }
  #undef CMASK
  #define CMASK(P0,P1,t) do{int jb_=(t)-(NT-4); if(jb_>=0)cmask(P0,P1,jb_,qrel,hi);}while(0)
  #define ENDW(tt) do{ if((tt)+3<NT){WAIT_BAR(2);} else if((tt)+2<NT){WAIT_BAR(1);} else {WAIT_BAR(0);} }while(0)
  for(;t+1<NT;t+=2){
    STEP(pB0,pB1,pA0,pA1,t,(t+3<NT),(t+1<NT),(t+1<NT));       ENDW(t);   RESC(); ROT();
    STEP(pA0,pA1,pB0,pB1,t+1,(t+4<NT),(t+2<NT),(t+2<NT));     ENDW(t+1); RESC(); ROT();
  }
  STEP(pB0,pB1,pA0,pA1,NT-1,false,false,false); RESC();
  { float sacc=pB0[0]+pB0[1]; _Pragma("unroll") for(int r=2;r<16;++r)sacc+=pB0[r]; _Pragma("unroll") for(int r=0;r<16;++r)sacc+=pB1[r]; l_reg+=sacc;
    pw0=(u32x4){PKW(pB0,0),PKW(pB0,2),PKW(pB0,4),PKW(pB0,6)};pw1=(u32x4){PKW(pB0,8),PKW(pB0,10),PKW(pB0,12),PKW(pB0,14)};pw2=(u32x4){PKW(pB1,0),PKW(pB1,2),PKW(pB1,4),PKW(pB1,6)};pw3=(u32x4){PKW(pB1,8),PKW(pB1,10),PKW(pB1,12),PKW(pB1,14)};
    SBAR(); pv(o,vb0+sl_cur,PAF(0),PAF(1),PAF(2),PAF(3)); }
  #undef PKW
  #undef PAF
  #undef VFR
  #undef PIN
  #undef MX3
  #undef GAPA
  #undef QKM
  #undef GAPB
  #undef EX
  #undef VRD
  #undef KRD
  #undef STEP
  #undef ENDW
  {auto rr=__builtin_amdgcn_permlane32_swap(__float_as_uint(l_reg),__float_as_uint(l_reg),false,false);l_reg=__uint_as_float(rr[0])+__uint_as_float(rr[1]);}
  if(hi==0)wsf[32+r32]=l_reg;asm volatile("s_waitcnt lgkmcnt(0)":::"memory");
  float rli[16];
  #pragma unroll
  for(int r=0;r<16;++r)rli[r]=__builtin_amdgcn_rcpf(wsf[32+crow(r,hi)]);
  { bf16*stg=(bf16*)(shm+(MODE==1?LDS_OA:LDS_OST))+wid*2048;
    #pragma unroll
    for(int r=0;r<16;++r){const int orow=crow(r,hi);
      #pragma unroll
      for(int d0=0;d0<2;++d0)stg[orow*64+d0*32+r32]=__float2bfloat16(o[d0][r]*rli[r]);}
    asm volatile("s_waitcnt lgkmcnt(0)":::"memory");
    if constexpr(MODE==0){ bf16*Ow=O+(rowbase+q0+wid*QBLK)*QP+h*D;
      #pragma unroll
      for(int i=0;i<4;++i){const int row=i*8+(lane>>3),ch=lane&7; const u32x4 v=*(const u32x4*)(stg+row*64+ch*8); ATTN_STORE16(Ow+(long)row*QP+ch*8,v);} }
    if constexpr(MODE==2){ const bf16*stgA=(const bf16*)(shm+LDS_OA)+wid*2048; bf16*Yw=O+(rowbase+q0+wid*QBLK)*1024+(h>>1)*D;
      const int ch=lane&7; float gg[8];
      #pragma unroll
      for(int j=0;j<8;++j)gg[j]=dg[ch*8+j];
      #pragma unroll
      for(int i=0;i<4;++i){const int row=i*8+(lane>>3); const u32x4 v2=*(const u32x4*)(stg+row*64+ch*8), v1=*(const u32x4*)(stgA+row*64+ch*8);
        float ov[8]; float ss=0.f;
        #pragma unroll
        for(int j=0;j<4;++j){ const float a0=__uint_as_float(v1[j]<<16),a1=__uint_as_float(v1[j]&0xffff0000u),c0=__uint_as_float(v2[j]<<16),c1=__uint_as_float(v2[j]&0xffff0000u);
          ov[2*j]=a0-lam*c0; ov[2*j+1]=a1-lam*c1; ss+=ov[2*j]*ov[2*j]+ov[2*j+1]*ov[2*j+1]; }
        ss+=__shfl_xor(ss,1); ss+=__shfl_xor(ss,2); ss+=__shfl_xor(ss,4);
        const float rs=omli/sqrtf(ss*(1.0f/64.0f)+1e-5f); u32x4 w;
        #pragma unroll
        for(int j=0;j<4;++j)w[j]=cvtpk_s(ov[2*j]*rs*gg[2*j],ov[2*j+1]*rs*gg[2*j+1]);
        ATTN_STORE16(Yw+(long)row*1024+ch*8,w);} } }
  asm volatile("s_waitcnt lgkmcnt(0)\n\ts_barrier":::"memory");
  #undef DMA_K
  #undef DMA_V
  #undef CMASK
  #undef START
  #undef RESC
  #undef ROT
}
constexpr int ATTN_LDS_BYTES=LDS_BYTES;
#undef SBAR
#undef WAIT_BAR
}
#define GAS __attribute__((address_space(1)))
#define LAS __attribute__((address_space(3)))
typedef unsigned short bf16;
typedef unsigned v4u __attribute__((ext_vector_type(4)));
typedef float f32x4 __attribute__((ext_vector_type(4)));
typedef short bf16x8 __attribute__((ext_vector_type(8)));
typedef GAS unsigned gu32;
typedef GAS unsigned long long gu64;
#define RLX_AGENT __ATOMIC_RELAXED, __HIP_MEMORY_SCOPE_AGENT
#define LDS_WAIT() asm volatile("s_waitcnt lgkmcnt(0)" ::: "memory")
#define VM_WAIT() asm volatile("s_waitcnt vmcnt(0)" ::: "memory")
__device__ __forceinline__ unsigned long long rt() { return __builtin_amdgcn_s_memrealtime(); }
__device__ __forceinline__ unsigned f2bf(float f) { unsigned u = __builtin_bit_cast(unsigned, f); return (u + 0x7fffu + ((u >> 16) & 1u)) >> 16; }
__device__ __forceinline__ unsigned pk2(float lo, float hi) { return f2bf(lo) | (f2bf(hi) << 16); }

#define XB_TMO      128
#define XB_XCNT(j)  (256  + 64 * (j))
#define XB_XSUB(j)  (1280 + 64 * (j))
#define XB_XGEN(j)  (2304 + 64 * (j))
#define XB_TOP      3328
#define XB_TOPGEN   3392
#define XCD_BAR_WORDS 3456
#define XB_SPIN_CAP (1u << 18)

__device__ __forceinline__ unsigned xb_ld(unsigned* p)              { return __hip_atomic_load(p, __ATOMIC_RELAXED, __HIP_MEMORY_SCOPE_AGENT); }
__device__ __forceinline__ unsigned xb_add(unsigned* p, unsigned v) { return __hip_atomic_fetch_add(p, v, __ATOMIC_RELAXED, __HIP_MEMORY_SCOPE_AGENT); }
__device__ __forceinline__ unsigned xb_xcc_id() { return (unsigned)__builtin_amdgcn_s_getreg((3 << 11) | 20) & 0xFu; }
#define XB_SPIN(cond, bar) do { unsigned _sp = 0; while (cond) { __builtin_amdgcn_s_sleep(1); \
    if ((++_sp & 255u) == 0u) { if (xb_ld(&(bar)[XB_TMO])) break; if (_sp > XB_SPIN_CAP) { atomicAdd(&(bar)[XB_TMO], 1u); break; } } } } while (0)

struct XcdBarrier {
    unsigned* bar; unsigned x;
    volatile LAS unsigned* st;
};

__device__ __forceinline__ XcdBarrier xcd_barrier_post(unsigned* bar, volatile LAS unsigned* st) {
    XcdBarrier b; b.bar = bar; b.x = xb_xcc_id(); b.st = st;
    if (threadIdx.x == 0) (void)xb_add(&bar[XB_XCNT(b.x)], 1u);
    return b;
}
__device__ __forceinline__ void xcd_barrier_complete(unsigned* bar, unsigned x, unsigned& nloc, unsigned& nx) {
    const unsigned G = gridDim.x * gridDim.y * gridDim.z;
    unsigned sum, cnt, mine, sp = 0u;
    for (;;) {
        sum = 0u; cnt = 0u; mine = 0u;
#pragma unroll
        for (unsigned j = 0; j < 16; ++j) { const unsigned c = xb_ld(&bar[XB_XCNT(j)]); sum += c; cnt += (c > 0u) ? 1u : 0u; mine = (j == x) ? c : mine; }
        if (sum == G) break;
        __builtin_amdgcn_s_sleep(1);
        if ((++sp & 255u) == 0u) { if (xb_ld(&bar[XB_TMO])) break; if (sp > XB_SPIN_CAP) { atomicAdd(&bar[XB_TMO], 1u); break; } }
    }
    nloc = mine > 0u ? mine : 1u; nx = cnt > 0u ? cnt : 1u;
}

__device__ __forceinline__ void xcd_barrier(const XcdBarrier& b) {
    asm volatile("s_waitcnt vmcnt(0)" ::: "memory");
    __syncthreads();
    if (threadIdx.x == 0) {
        unsigned* bar = b.bar;
        __builtin_amdgcn_s_waitcnt(0);
        unsigned nloc = b.st[0], nx = b.st[1];
        if (nloc == 0u) { xcd_barrier_complete(bar, b.x, nloc, nx); b.st[0] = nloc; b.st[1] = nx; }
        const unsigned old = xb_add(&bar[XB_XSUB(b.x)], 1u);
        const unsigned gen = old / nloc;
        if (old + 1u == (gen + 1u) * nloc) {
            __builtin_amdgcn_fence(__ATOMIC_RELEASE, "agent");
            asm volatile("s_waitcnt vmcnt(0)" ::: "memory");
            const unsigned og = xb_add(&bar[XB_TOP], 1u);
            const unsigned tg = og / nx;
            if (og + 1u == (tg + 1u) * nx) xb_add(&bar[XB_TOPGEN], 1u);
            else XB_SPIN(xb_ld(&bar[XB_TOPGEN]) == tg, bar);
            __builtin_amdgcn_fence(__ATOMIC_ACQUIRE, "agent");
            xb_add(&bar[XB_XGEN(b.x)], 1u);
            asm volatile("s_waitcnt vmcnt(0)" ::: "memory");
        } else {
            XB_SPIN(xb_ld(&bar[XB_XGEN(b.x)]) == gen, bar);
            __builtin_amdgcn_fence(__ATOMIC_ACQUIRE, "agent");
            asm volatile("s_waitcnt vmcnt(0)" ::: "memory");
        }
    }
    __syncthreads();
}
constexpr int NWAVES = 8;
constexpr int NB = 8, SEQ = 4096, DM = 1024, T = NB * SEQ;
constexpr int GW = 256, NIN = 2304, DFF = 2816, NE = 8, DFE = 3584, CONVW = 31;
constexpr int MOE_CHUNK_TILES = 64, MOE_NCHUNK = 5, MOE_MAX_ROWS = 264 * 256;
#ifndef MK_PER_PHASE
#define MK_PER_PHASE 0
#endif
constexpr int N_PHASES = 15 + MOE_NCHUNK;
#ifndef PROBE_DUP
#define PROBE_DUP 0ull
#endif
#define DUPN(k) (1 + (int)((PROBE_DUP >> (k)) & 1ull))
static_assert(MOE_CHUNK_TILES * MOE_NCHUNK * 256 >= MOE_MAX_ROWS, "MoE chunks cover every row tile");

constexpr size_t KiB = 1024, MiB = 1u << 20;
constexpr size_t WS_CTL = 0, CTL_ZERO_BYTES = 64 * KiB;
constexpr int CW_TMO = 0, CW_CODE = 1, CW_BAR = 4096, CW_ECNT = 8192;
constexpr size_t WS_TAB = 1 * MiB;
constexpr size_t WS_ROPEC = WS_TAB, WS_ROPED = WS_TAB + 256 * KiB, WS_MISC = WS_TAB + 384 * KiB, WS_SS0 = WS_TAB + 448 * KiB, WS_LSE = WS_TAB + 576 * KiB;
constexpr size_t WS_TOKE = WS_TAB + 2112 * KiB, WS_TOKG = WS_TAB + 2368 * KiB, WS_TOKP = WS_TAB + 2624 * KiB, WS_SSROW = WS_TAB + 2880 * KiB, WS_SST = WS_TAB + 3152 * KiB;
constexpr size_t WS_W = 4608 * KiB;
constexpr size_t SZ_WIN = (size_t)NIN * DM * 2, SZ_WOUT = (size_t)DM * DM * 2, SZ_W1 = (size_t)2 * DFF * DM * 2, SZ_W2 = (size_t)DM * DFF * 2, SZ_W1E = (size_t)2 * DFE * DM, SZ_W2E = (size_t)DM * DFE;
constexpr size_t WS_WIN = WS_W, WS_WOUT = WS_WIN + 2 * SZ_WIN, WS_W1 = WS_WOUT + 2 * SZ_WOUT, WS_W2 = WS_W1 + SZ_W1, WS_W1E = WS_W2 + SZ_W2, WS_W2E = WS_W1E + NE * SZ_W1E, WS_WEND = WS_W2E + NE * SZ_W2E;
constexpr size_t WS_ACT = 202 * MiB;
static_assert(WS_SSROW + (size_t)MOE_MAX_ROWS * 4 <= WS_SST && WS_SST + (size_t)T * 4 <= WS_W && WS_WEND <= WS_ACT, "d_ws map: tables / weights");
constexpr size_t SZ_TB = (size_t)T * 256 * 2;
constexpr size_t WS_XB = WS_ACT;
constexpr size_t WS_UB = WS_ACT + 64 * MiB;
constexpr size_t WS_QD = WS_UB + 7 * SZ_TB;
constexpr size_t WS_Y = WS_ACT + 208 * MiB;
constexpr size_t WS_OC = WS_ACT + 272 * MiB;
constexpr size_t WS_SSP = WS_OC;
constexpr size_t WS_XB8 = WS_ACT + 64 * MiB;
constexpr size_t WS_HID = WS_ACT + 64 * MiB;
constexpr size_t WS_Y2 = WS_ACT + 242 * MiB;
constexpr size_t WS_HS = WS_ACT + 176 * MiB;
constexpr size_t WS_HIDE = WS_ACT + 64 * MiB, SZ_HIDE = (size_t)MOE_CHUNK_TILES * 256 * DFE;
constexpr size_t WS_END = WS_ACT + 320 * MiB;
static_assert(WS_QD + (size_t)T * 512 * 2 == WS_Y && WS_Y + (size_t)T * 1024 * 2 == WS_OC && WS_OC + 3 * SZ_TB == WS_END, "d_ws map: activations");
static_assert(WS_HID + (size_t)T * DFF * 2 <= WS_OC && WS_Y2 + (size_t)MOE_MAX_ROWS * 1024 <= WS_END && WS_HS + (size_t)MOE_MAX_ROWS * 1024 <= WS_Y2 && WS_HIDE + 2 * SZ_HIDE <= WS_HS && WS_XB + (size_t)T * 2048 <= WS_HIDE, "d_ws map: FFN overlays");

constexpr int RING_OFF = 0, RING_BYTES = 131072;
constexpr int LDSCTL_OFF = RING_BYTES, MISC_OFF = LDSCTL_OFF + 320;
constexpr int LDS_BYTES = 147456;
__device__ __forceinline__ float bf2f(unsigned short b) { return __uint_as_float((unsigned)b << 16); }
__device__ __forceinline__ float wave_sum(float v) {
#pragma unroll
    for (int o = 1; o < 64; o <<= 1) v += __shfl_xor(v, o);
    return v;
}
typedef float f32x16v __attribute__((ext_vector_type(16)));
typedef short s16x4v __attribute__((ext_vector_type(4)));
typedef unsigned v2u __attribute__((ext_vector_type(2)));

__device__ __forceinline__ const float* inp(const LAS unsigned char* lds, int i) {
    int i_ = i; asm volatile("" : "+s"(i_));
    const LAS unsigned* p = (const LAS unsigned*)(lds + LDSCTL_OFF) + 2 * i_;
    const unsigned lo = __builtin_amdgcn_readfirstlane(p[0]), hi = __builtin_amdgcn_readfirstlane(p[1]);
    return (const float*)(const GAS float*)(((unsigned long long)hi << 32) | lo);
}
__device__ __forceinline__ void tr_item(const float* W, int ldw, const float* gk, bf16* WT, int ldt, int k0, int sc0, int dr0, bool hperm, LAS float* scr, int lane) {
    { float v[32];
#pragma unroll
      for (int i = 0; i < 32; ++i) v[i] = W[(size_t)(k0 + 2 * i + (lane >> 5)) * ldw + sc0 + (lane & 31)];
      if (gk) {
#pragma unroll
          for (int i = 0; i < 32; ++i) v[i] *= gk[k0 + 2 * i + (lane >> 5)]; }
#pragma unroll
      for (int i = 0; i < 32; ++i) scr[(2 * i + (lane >> 5)) * 33 + (lane & 31)] = v[i]; }
    LDS_WAIT(); asm volatile("" ::: "memory");
    const int c = lane & 7;
#pragma unroll
    for (int j = 0; j < 4; ++j) { const int n = (lane >> 3) + 8 * j; int ns = n; if (hperm && n < 16) ns = ((n >> 2) & 1) * 8 + (n >> 3) * 4 + (n & 3);
        const LAS float* s = scr + (8 * c) * 33 + ns;
        v4u o; o.x = pk2(s[0 * 33], s[1 * 33]); o.y = pk2(s[2 * 33], s[3 * 33]); o.z = pk2(s[4 * 33], s[5 * 33]); o.w = pk2(s[6 * 33], s[7 * 33]);
        *(GAS v4u*)(WT + (size_t)(dr0 + n) * ldt + k0 + 8 * c) = o; }
    LDS_WAIT(); asm volatile("" ::: "memory");
}
__device__ __forceinline__ void tr_item8(const float* W, int ldw, const float* gk, unsigned char* WT, int ldt, int k0, int sc0, int dr0, LAS float* scr, int lane) {
    { float v[32];
#pragma unroll
      for (int i = 0; i < 32; ++i) v[i] = W[(size_t)(k0 + 2 * i + (lane >> 5)) * ldw + sc0 + (lane & 31)];
      if (gk) {
#pragma unroll
          for (int i = 0; i < 32; ++i) v[i] *= gk[k0 + 2 * i + (lane >> 5)]; }
#pragma unroll
      for (int i = 0; i < 32; ++i) scr[(2 * i + (lane >> 5)) * 33 + (lane & 31)] = v[i] * pg8::F8_WGT; }
    LDS_WAIT(); asm volatile("" ::: "memory");
    const int c = lane & 7;
#pragma unroll
    for (int j = 0; j < 4; ++j) { const int n = (lane >> 3) + 8 * j; const LAS float* s = scr + (8 * c) * 33 + n;
        v2u o; o.x = pg8::pack4_fp8(s[0 * 33], s[1 * 33], s[2 * 33], s[3 * 33]); o.y = pg8::pack4_fp8(s[4 * 33], s[5 * 33], s[6 * 33], s[7 * 33]);
        *(GAS v2u*)(WT + (size_t)(dr0 + n) * ldt + k0 + 8 * c) = o; }
    LDS_WAIT(); asm volatile("" ::: "memory");
}
__device__ __forceinline__ void tr_glu_item16(const float* Wg, const float* Wu, int F, const float* gk, bf16* WT, int item, LAS float* scr, int lane) {
    const int nblk = 2 * F / 32, kb = item / nblk, nb = item % nblk, tile = nb >> 3, j = nb & 7;
    tr_item(j < 4 ? Wg : Wu, F, gk, WT, DM, 64 * kb, 128 * tile + 32 * (j & 3), 32 * nb, false, scr, lane);
}
__device__ __forceinline__ void tr_glu_item(const float* Wg, const float* Wu, int F, const float* gk, unsigned char* WT, int item, LAS float* scr, int lane) {
    const int nblk = 2 * F / 32, kb = item / nblk, nb = item % nblk, tile = nb >> 3, j = nb & 7;
    tr_item8(j < 4 ? Wg : Wu, F, gk, WT, DM, 64 * kb, 128 * tile + 32 * (j & 3), 32 * nb, scr, lane);
}
#define IN_(i) inp(lds, (i))
struct TrP { const float* W; const float* gk; unsigned char* WT; int ldw, ldt, k0, sc0, dr0, mode; };
__device__ __forceinline__ TrP tr_glu(const float* Wg, const float* Wu, int F, const float* gk, unsigned char* WT, int item, int mode) {
    const int nblk = 2 * F / 32, kb = item / nblk, nb = item % nblk, tile = nb >> 3, j = nb & 7;
    return TrP{j < 4 ? Wg : Wu, gk, WT, F, DM, 64 * kb, 128 * tile + 32 * (j & 3), 32 * nb, mode};
}
__device__ __forceinline__ TrP tr_decode(int it, unsigned char* ws, const LAS unsigned char* lds) {
    constexpr int I_IN = 16 * 72, I_OUT = 8 * 32, I_F1 = 16 * (2 * DFF / 32), I_F2 = (DFF / 64) * 32, I_E1 = 16 * (2 * DFE / 32), I_E2 = (DFE / 64) * 32;
    int r = it;
    if (r < 2 * I_IN) { const int l = r / I_IN; r -= l * I_IN; const int kb = r / 72, nb = r % 72, tile = nb >> 3, j = nb & 7;
        int sc0; if (tile == 0) sc0 = (j < 4) ? 32 * j : 256 + 32 * (j - 4); else if (tile == 1) sc0 = (j < 4) ? 128 + 32 * j : 384 + 32 * (j - 4); else sc0 = 256 * tile + 32 * j;
        return TrP{IN_(2) + (size_t)l * DM * NIN, IN_(1) + l * DM, ws + WS_WIN + l * SZ_WIN, NIN, DM, 64 * kb, sc0, 32 * nb, ((tile == 3 || tile == 4) && ((j & 1) == 0)) ? 1 : 0}; }
    r -= 2 * I_IN;
    if (r < 2 * I_OUT) { const int l = r / I_OUT; r -= l * I_OUT; const int kb = 8 + r / 32, nb = r % 32;
        return TrP{IN_(12) + (size_t)l * DM * DM, nullptr, ws + WS_WOUT + l * SZ_WOUT, DM, DM, 64 * kb, 32 * nb, 32 * nb, 0}; }
    r -= 2 * I_OUT;
    if (r < I_F1) return tr_glu(IN_(14), IN_(15), DFF, IN_(13), ws + WS_W1, r, 0);
    r -= I_F1;
    if (r < I_F2) { const int kb = r / 32, nb = r % 32; return TrP{IN_(16), nullptr, ws + WS_W2, DM, DFF, 64 * kb, 32 * nb, 32 * nb, 0}; }
    r -= I_F2;
    if (r < NE * I_E1) { const int e = r / I_E1; r -= e * I_E1; return tr_glu(IN_(18) + (size_t)e * DM * DFE, IN_(19) + (size_t)e * DM * DFE, DFE, IN_(13) + DM, ws + WS_W1E + e * SZ_W1E, r, 2); }
    r -= NE * I_E1;
    { const int e = r / I_E2; r -= e * I_E2; const int kb = r / 32, nb = r % 32; return TrP{IN_(20) + (size_t)e * DFE * DM, nullptr, ws + WS_W2E + e * SZ_W2E, DM, DFE, 64 * kb, 32 * nb, 32 * nb, 2}; }
}
__device__ __forceinline__ void tr_load(const TrP& p, float (&v)[32], f32x4 (&g)[2], int lane) {
#pragma unroll
    for (int i = 0; i < 8; ++i) { const f32x4 q = __builtin_nontemporal_load((const f32x4*)(p.W + (size_t)(p.k0 + 8 * i + (lane >> 3)) * p.ldw + p.sc0 + 4 * (lane & 7)));
        v[4 * i] = q.x; v[4 * i + 1] = q.y; v[4 * i + 2] = q.z; v[4 * i + 3] = q.w; }
    if (p.gk) { g[0] = *(const f32x4*)(p.gk + p.k0 + 8 * (lane & 7)); g[1] = *(const f32x4*)(p.gk + p.k0 + 8 * (lane & 7) + 4); }
    else { g[0] = (f32x4){1.f, 1.f, 1.f, 1.f}; g[1] = g[0]; }
}
__device__ __forceinline__ void tr_finish(const TrP& p, const float (&v)[32], const f32x4 (&g)[2], LAS float* scr, int lane) {
#pragma unroll
    for (int i = 0; i < 8; ++i)
#pragma unroll
        for (int q = 0; q < 4; ++q) scr[(8 * i + (lane >> 3)) * 33 + 4 * (lane & 7) + q] = v[4 * i + q];
    LDS_WAIT(); asm volatile("" ::: "memory");
    const int c = lane & 7;
#pragma unroll
    for (int j = 0; j < 4; ++j) { const int n = (lane >> 3) + 8 * j; int ns = n; if (p.mode == 1 && n < 16) ns = ((n >> 2) & 1) * 8 + (n >> 3) * 4 + (n & 3);
        const LAS float* s = scr + (8 * c) * 33 + ns;
        const float a0 = s[0 * 33] * g[0].x, a1 = s[1 * 33] * g[0].y, a2 = s[2 * 33] * g[0].z, a3 = s[3 * 33] * g[0].w, a4 = s[4 * 33] * g[1].x, a5 = s[5 * 33] * g[1].y, a6 = s[6 * 33] * g[1].z, a7 = s[7 * 33] * g[1].w;
        if (p.mode == 2) { v2u o; o.x = pg8::pack4_fp8(a0 * pg8::F8_WGT, a1 * pg8::F8_WGT, a2 * pg8::F8_WGT, a3 * pg8::F8_WGT); o.y = pg8::pack4_fp8(a4 * pg8::F8_WGT, a5 * pg8::F8_WGT, a6 * pg8::F8_WGT, a7 * pg8::F8_WGT);
            __builtin_nontemporal_store(o, (GAS v2u*)(p.WT + (size_t)(p.dr0 + n) * p.ldt + p.k0 + 8 * c)); }
        else { v4u o; o.x = pk2(a0, a1); o.y = pk2(a2, a3); o.z = pk2(a4, a5); o.w = pk2(a6, a7); *(GAS v4u*)((bf16*)p.WT + (size_t)(p.dr0 + n) * p.ldt + p.k0 + 8 * c) = o; } }
    LDS_WAIT(); asm volatile("" ::: "memory");
}
constexpr int TR_N0 = 2 * (16 * 72) + 2 * (8 * 32) + 16 * (2 * DFF / 32) + (DFF / 64) * 32;
constexpr int TR_NALL = TR_N0 + NE * (16 * (2 * DFE / 32)) + NE * ((DFE / 64) * 32);
__device__ __forceinline__ void tr_loop(unsigned char* ws, const LAS unsigned char* lds, int first, int count, int widx, int nw, LAS float* scr, int lane) {
    TrP pa, pb; float va[32], vb[32]; f32x4 ga[2], gb[2];
    int it = widx; bool ha = it < count; if (ha) { pa = tr_decode(first + it, ws, lds); tr_load(pa, va, ga, lane); }
    while (ha) {
        const int itb = it + nw; const bool hb = itb < count; if (hb) { pb = tr_decode(first + itb, ws, lds); tr_load(pb, vb, gb, lane); }
        tr_finish(pa, va, ga, scr, lane);
        if (!hb) break;
        it = itb + nw; ha = it < count; if (ha) { pa = tr_decode(first + it, ws, lds); tr_load(pa, va, ga, lane); }
        tr_finish(pb, vb, gb, scr, lane);
    }
}
__device__ __forceinline__ void tr_share(unsigned char* ws, const LAS unsigned char* lds, int bx, int G, int wave, int lane) {
    const int n5 = ((T / 256) * (NIN / 256)) % G; constexpr int CW = 4;
    const int wgt = (n5 == 0 || bx < n5) ? 1 : CW, vbase = (n5 == 0 || bx < n5) ? bx : n5 + (bx - n5) * CW, total = (n5 == 0) ? G : n5 + (G - n5) * CW;
    for (int j = 0; j < wgt; ++j) tr_loop(ws, lds, TR_N0, TR_NALL - TR_N0, (vbase + j) * NWAVES + wave, total * NWAVES, (LAS float*)(lds + RING_OFF + wave * 16384), lane);
}
__device__ __forceinline__ void p0_prologue(unsigned char* ws, LAS unsigned char* lds, int vcu, int G, int tid, int lane, int wave) {
    LAS float* scr = (LAS float*)(lds + RING_OFF + wave * 16384);
    const float* x = IN_(0);
    constexpr int I_IN = 16 * 72, I_OUT = 8 * 32, I_F1 = 16 * (2 * DFF / 32), I_F2 = (DFF / 64) * 32, I_E1 = 16 * (2 * DFE / 32), I_E2 = (DFE / 64) * 32;
    constexpr int NITEMS = 2 * I_IN + 2 * I_OUT + I_F1 + I_F2 + NE * I_E1 + NE * I_E2; static_assert(NITEMS == TR_NALL, "item count");
    if (wave < 2) for (int fi = vcu; fi < 256; fi += G) { const int l = fi >> 7, kb = ((fi >> 2) & 31) + 32 * wave, n4 = (fi & 3) * 64 + lane;
          f32x4 a[8];
#pragma unroll
          for (int i = 0; i < 8; ++i) a[i] = (f32x4){0.f, 0.f, 0.f, 0.f};
          if (kb < 32) { const float* pw = IN_(7) + (size_t)l * GW * GW + (size_t)kb * 8 * GW; const float* wo = IN_(12) + (size_t)l * DM * DM + 4 * n4;
#pragma unroll 1
              for (int j = 0; j < 256; j += 4) { f32x4 w[4];
#pragma unroll
                  for (int jj = 0; jj < 4; ++jj) w[jj] = *(const f32x4*)(wo + (size_t)(j + jj) * DM);
#pragma unroll
                  for (int i = 0; i < 8; ++i) { const f32x4 pv = *(const f32x4*)(pw + i * GW + j); a[i] += pv.x * w[0]; a[i] += pv.y * w[1]; a[i] += pv.z * w[2]; a[i] += pv.w * w[3]; } } }
          else { const int g = (kb - 32) >> 3, p0 = ((kb - 32) & 7) * 8; const float* pw = IN_(8) + (size_t)l * 4 * 64 * 64 + (size_t)(g * 64 + p0) * 64; const float* sc = IN_(9) + l * GW + 64 * g;
              const float* wo = IN_(12) + (size_t)l * DM * DM + (size_t)(256 + 64 * g) * DM + 4 * n4;
#pragma unroll 1
              for (int q = 0; q < 64; q += 4) { f32x4 w[4]; const f32x4 s4 = *(const f32x4*)(sc + q);
#pragma unroll
                  for (int jj = 0; jj < 4; ++jj) w[jj] = *(const f32x4*)(wo + (size_t)(q + jj) * DM) * s4[jj];
#pragma unroll
                  for (int i = 0; i < 8; ++i) { const f32x4 pv = *(const f32x4*)(pw + i * 64 + q); a[i] += pv.x * w[0]; a[i] += pv.y * w[1]; a[i] += pv.z * w[2]; a[i] += pv.w * w[3]; } } }
          bf16* wt = (bf16*)(ws + WS_WOUT + l * SZ_WOUT) + (size_t)(4 * n4) * DM + kb * 8;
          { v4u o0, o1, o2, o3; o0.x = pk2(a[0].x, a[1].x); o0.y = pk2(a[2].x, a[3].x); o0.z = pk2(a[4].x, a[5].x); o0.w = pk2(a[6].x, a[7].x);
            o1.x = pk2(a[0].y, a[1].y); o1.y = pk2(a[2].y, a[3].y); o1.z = pk2(a[4].y, a[5].y); o1.w = pk2(a[6].y, a[7].y);
            o2.x = pk2(a[0].z, a[1].z); o2.y = pk2(a[2].z, a[3].z); o2.z = pk2(a[4].z, a[5].z); o2.w = pk2(a[6].z, a[7].z);
            o3.x = pk2(a[0].w, a[1].w); o3.y = pk2(a[2].w, a[3].w); o3.z = pk2(a[4].w, a[5].w); o3.w = pk2(a[6].w, a[7].w);
            *(GAS v4u*)(wt) = o0; *(GAS v4u*)(wt + DM) = o1; *(GAS v4u*)(wt + 2 * DM) = o2; *(GAS v4u*)(wt + 3 * DM) = o3; } }
    if (wave == 1) { float* rc = (float*)(ws + WS_ROPEC); float* rd = (float*)(ws + WS_ROPED);
      for (int it = vcu * 64 + lane; it < SEQ * 12; it += G * 64) { const int pos = it / 12, i = it % 12;
          const float inv = (i < 8) ? powf(500000.0f, -(float)(2 * i) / 16.0f) : powf(500000.0f, -(float)(2 * (i - 8)) / 8.0f);
          const float ang = (float)pos * inv; double rv = (double)ang * 0.15915494309189535; rv -= floor(rv); const float fr_ = (float)rv;
          const float cs = __builtin_amdgcn_cosf(fr_), sn = __builtin_amdgcn_sinf(fr_);
          if (i < 8) { rc[pos * 16 + (i >> 2) * 8 + (i & 3)] = cs; rc[pos * 16 + (i >> 2) * 8 + 4 + (i & 3)] = sn; }
          else { const int i2 = i - 8; rd[pos * 8 + i2] = cs; rd[pos * 8 + 4 + i2] = sn; } } }
    if (wave == 2 && vcu < 2 && lane == 0) { const int l = vcu; const float* lv = IN_(10) + l * 128; float s01 = 0.f, s23 = 0.f; for (int j = 0; j < 32; ++j) { s01 += lv[j] * lv[32 + j]; s23 += lv[64 + j] * lv[96 + j]; }
          const float li = 0.8f - 0.6f * expf(-0.3f * (float)l); float* mi = (float*)(ws + WS_MISC); mi[2 * l] = expf(s01) - expf(s23) + li; mi[2 * l + 1] = 1.0f - li; }
    if (wave > 0) tr_loop(ws, lds, 0, TR_N0, vcu + G * (NWAVES - 1 - wave), G * (NWAVES - 1), scr, lane);
    { bf16* xb = (bf16*)(ws + WS_XB); float* ss0 = (float*)(ws + WS_SS0);
      if (wave > 0) for (int m = 2 * (NWAVES - 1 - wave) * G + vcu; m < T; m += 2 * (NWAVES - 1) * G) { const int m2 = m + G;
          const GAS f32x4* xr = (const GAS f32x4*)(x + (size_t)m * DM) + lane; const GAS f32x4* xr2 = (const GAS f32x4*)(x + (size_t)(m2 < T ? m2 : m) * DM) + lane;
          f32x4 v[4], w2[4];
#pragma unroll
          for (int j = 0; j < 4; ++j) { v[j] = __builtin_nontemporal_load(xr + 64 * j); w2[j] = __builtin_nontemporal_load(xr2 + 64 * j); }
          GAS v2u* o8 = (GAS v2u*)(xb + (size_t)m * DM) + lane; GAS v2u* o82 = (GAS v2u*)(xb + (size_t)(m2 < T ? m2 : m) * DM) + lane; float s = 0.f, s2 = 0.f;
#pragma unroll
          for (int j = 0; j < 4; ++j) { s += (v[j].x * v[j].x + v[j].y * v[j].y) + (v[j].z * v[j].z + v[j].w * v[j].w); s2 += (w2[j].x * w2[j].x + w2[j].y * w2[j].y) + (w2[j].z * w2[j].z + w2[j].w * w2[j].w);
              v2u w; w.x = pk2(v[j].x, v[j].y); w.y = pk2(v[j].z, v[j].w); o8[64 * j] = w; if (m2 < T) { v2u q; q.x = pk2(w2[j].x, w2[j].y); q.y = pk2(w2[j].z, w2[j].w); o82[64 * j] = q; } }
          s = wave_sum(s); s2 = wave_sum(s2); if (lane == 0) { ss0[m] = s; if (m2 < T) ss0[m2] = s2; } } }
}
constexpr int CK_PITCH = 144, CV_OFF = 384 * CK_PITCH, CV_HALF = 384 * 64, CS_OFF = CV_OFF + 2 * CV_HALF;
static_assert(CS_OFF + NWAVES * 128 <= RING_BYTES, "dilated-attention LDS");
__device__ __forceinline__ s16x4v vtr16(const LAS unsigned char* p) { return __builtin_bit_cast(s16x4v, __builtin_amdgcn_ds_read_tr16_b64_v4i16((LAS s16x4v*)p)); }
__device__ __forceinline__ int crow16(int r, int hi) { return (r & 3) + 8 * (r >> 2) + 4 * hi; }
__device__ __forceinline__ void dil_load(int uc, const bf16* KC, const bf16* VC, int tid, v4u (&kr)[6], v4u (&vr)[6]) {
    const int br = uc >> 9, rem = uc & 511, bh = rem >> 4, blk = rem & 15, b = bh >> 2, h = bh & 3;
    const int sh = 2 * br, dil = 1 << sh, r = blk & (dil - 1), m0 = (blk >> sh) << 8;
    const size_t tok0 = (size_t)b * SEQ;
#pragma unroll
    for (int it = 0; it < 6; ++it) { const int i = tid + it * (NWAVES * 64), j = i >> 3, ch = i & 7, m = m0 - 128 + j, mm = m < 0 ? 0 : m;
        const size_t off = (tok0 + ((size_t)mm << sh) + r) * 256 + h * 64 + ch * 8; kr[it] = *(const GAS v4u*)(KC + off); vr[it] = *(const GAS v4u*)(VC + off); }
}
__device__ __forceinline__ void dil_stage(int uc, const v4u (&kr)[6], const v4u (&vr)[6], LAS unsigned char* lds, int tid) {
    const int br = uc >> 9, blk = uc & 15, sh = 2 * br, m0 = (blk >> sh) << 8;
#pragma unroll
    for (int it = 0; it < 6; ++it) { const int i = tid + it * (NWAVES * 64), j = i >> 3, ch = i & 7, m = m0 - 128 + j;
        const v4u z = (v4u){0u, 0u, 0u, 0u};
        *(LAS v4u*)(lds + j * CK_PITCH + ch * 16) = (m >= 0) ? kr[it] : z;
        *(LAS v4u*)(lds + CV_OFF + (ch >> 2) * CV_HALF + j * 64 + (ch & 3) * 16) = (m >= 0) ? vr[it] : z; }
}
__device__ __forceinline__ void dil_loadq(int uc, const bf16* QC, int lane, int wid, bf16x8 (&qr)[4]) {
    const int br = uc >> 9, rem = uc & 511, bh = rem >> 4, blk = rem & 15, b = bh >> 2, h = bh & 3;
    const int sh = 2 * br, dil = 1 << sh, r = blk & (dil - 1), m0 = (blk >> sh) << 8, r32 = lane & 31, hi = lane >> 5;
    const size_t qtok = (size_t)b * SEQ + ((size_t)(m0 + 32 * wid + r32) << sh) + r;
#pragma unroll
    for (int d0 = 0; d0 < 4; ++d0) qr[d0] = *(const GAS bf16x8*)(QC + qtok * 256 + h * 64 + d0 * 16 + hi * 8);
}
__device__ __forceinline__ void dil_compute(int uc, const bf16x8 (&qr)[4], bf16* OCb, float* LSEb, LAS unsigned char* lds, int lane, int wid, int ucn, const bf16* KC, const bf16* VC, int tid, v4u (&kr)[6], v4u (&vr)[6]) {
    const int br = uc >> 9, rem = uc & 511, bh = rem >> 4, blk = rem & 15, b = bh >> 2, h = bh & 3;
    const int sh = 2 * br, dil = 1 << sh, r = blk & (dil - 1), m0 = (blk >> sh) << 8;
    const size_t tok0 = (size_t)b * SEQ;
    bf16* OC = OCb + (size_t)br * T * 256; float* LSE = LSEb + (size_t)br * T * 4;
    const int r32 = lane & 31, hi = lane >> 5;
    const size_t qtok = tok0 + ((size_t)(m0 + 32 * wid + r32) << sh) + r;
    f32x16v S[5];
    const LAS unsigned char* kbase = lds + (32 * wid + r32) * CK_PITCH + hi * 16;
#pragma unroll
    for (int jb = 0; jb < 5; ++jb) { f32x16v a = {};
#pragma unroll
        for (int d0 = 0; d0 < 4; ++d0) { const bf16x8 kf = *(const LAS bf16x8*)(kbase + jb * 32 * CK_PITCH + d0 * 32); a = __builtin_amdgcn_mfma_f32_32x32x16_bf16(kf, qr[d0], a, 0, 0, 0); }
        S[jb] = a; }
    const int kmin = (m0 == 0) ? (128 - 32 * wid) : 0;
    { const int lo0 = r32 > kmin ? r32 : kmin;
#pragma unroll
      for (int rg = 0; rg < 16; ++rg) { const int c = crow16(rg, hi); if (c < lo0) S[0][rg] = -INFINITY; if (c > r32) S[4][rg] = -INFINITY; }
      if (kmin > 32) {
#pragma unroll
          for (int jb = 1; jb < 4; ++jb)
#pragma unroll
              for (int rg = 0; rg < 16; ++rg) { if (32 * jb + crow16(rg, hi) < kmin) S[jb][rg] = -INFINITY; }
      } }
    __builtin_amdgcn_sched_barrier(0);
    float mx = -INFINITY;
#pragma unroll
    for (int jb = 0; jb < 5; ++jb)
#pragma unroll
        for (int rg = 0; rg < 16; ++rg) mx = fmaxf(mx, S[jb][rg]);
    { auto rr = __builtin_amdgcn_permlane32_swap(__float_as_uint(mx), __float_as_uint(mx), false, false); mx = fmaxf(__uint_as_float(rr[0]), __uint_as_float(rr[1])); }
    float l = 0.f; pg8::u32x4 pw[5][2];
#pragma unroll
    for (int jb = 0; jb < 5; ++jb) {
#pragma unroll
        for (int rg = 0; rg < 16; ++rg) { const float p = __builtin_amdgcn_exp2f(S[jb][rg] - mx); S[jb][rg] = p; l += p; }
#pragma unroll
        for (int s2 = 0; s2 < 2; ++s2) { pw[jb][s2].x = pg8::cvt_pk_bf16(S[jb][8 * s2 + 0], S[jb][8 * s2 + 1]); pw[jb][s2].y = pg8::cvt_pk_bf16(S[jb][8 * s2 + 2], S[jb][8 * s2 + 3]);
            pw[jb][s2].z = pg8::cvt_pk_bf16(S[jb][8 * s2 + 4], S[jb][8 * s2 + 5]); pw[jb][s2].w = pg8::cvt_pk_bf16(S[jb][8 * s2 + 6], S[jb][8 * s2 + 7]); } }
    { auto rr = __builtin_amdgcn_permlane32_swap(__float_as_uint(l), __float_as_uint(l), false, false); l = __uint_as_float(rr[0]) + __uint_as_float(rr[1]); }
    if (ucn >= 0) dil_load(ucn, KC, VC, tid, kr, vr);
    f32x16v o0 = {}, o1 = {};
    const LAS unsigned char* vbase = lds + CV_OFF + ((lane >> 4) & 1) * 32 + (lane & 3) * 8 + (32 * wid + 4 * hi + ((lane & 15) >> 2)) * 64;
#pragma unroll
    for (int jb = 0; jb < 5; ++jb)
#pragma unroll
        for (int s2 = 0; s2 < 2; ++s2) {
            const bf16x8 pa = __builtin_bit_cast(bf16x8, pw[jb][s2]);
            const LAS unsigned char* vp = vbase + (32 * jb + 16 * s2) * 64;
            const s16x4v a0 = vtr16(vp), a1 = vtr16(vp + 512), c0 = vtr16(vp + CV_HALF), c1 = vtr16(vp + CV_HALF + 512);
            const bf16x8 v0 = (bf16x8){a0[0], a0[1], a0[2], a0[3], a1[0], a1[1], a1[2], a1[3]}, v1 = (bf16x8){c0[0], c0[1], c0[2], c0[3], c1[0], c1[1], c1[2], c1[3]};
            o0 = __builtin_amdgcn_mfma_f32_32x32x16_bf16(v0, pa, o0, 0, 0, 0); o1 = __builtin_amdgcn_mfma_f32_32x32x16_bf16(v1, pa, o1, 0, 0, 0); }
    if (hi == 0) LSE[qtok * 4 + h] = mx + __builtin_amdgcn_logf(l);
    { const float il = __builtin_amdgcn_rcpf(l);
      bf16* op = OC + qtok * 256 + h * 64 + 8 * hi;
#pragma unroll
      for (int hf = 0; hf < 2; ++hf)
#pragma unroll
          for (int kp = 0; kp < 4; kp += 2) { const f32x16v o = hf ? o1 : o0;
              const unsigned ax = pg8::cvt_pk_bf16(o[4 * kp] * il, o[4 * kp + 1] * il), ay = pg8::cvt_pk_bf16(o[4 * kp + 2] * il, o[4 * kp + 3] * il);
              const unsigned bx = pg8::cvt_pk_bf16(o[4 * kp + 4] * il, o[4 * kp + 5] * il), by = pg8::cvt_pk_bf16(o[4 * kp + 6] * il, o[4 * kp + 7] * il);
              unsigned ax_ = ax, ay_ = ay, bx_ = bx, by_ = by; asm volatile("s_nop 1" : "+v"(ax_), "+v"(ay_), "+v"(bx_), "+v"(by_));
              const auto r0 = __builtin_amdgcn_permlane32_swap(ax_, bx_, false, false); const auto r1 = __builtin_amdgcn_permlane32_swap(ay_, by_, false, false);
              v4u w; w.x = r0[0]; w.y = r1[0]; w.z = r0[1]; w.w = r1[1];
              *(GAS v4u*)(op + hf * 32 + 8 * kp) = w; } }
    __syncthreads();
}

template <int W> __device__ __forceinline__ void pool_run(const float (&pin)[47], int sbase, bf16* yo) {
#pragma unroll
    for (int i = 0; i < 32; ++i) { float s = 0.f;
#pragma unroll
        for (int j = 0; j < W; ++j) s += pin[15 + i - j];
        const int pos = sbase + i; const float cnt = (float)((pos + 1 < W) ? pos + 1 : W);
        yo[(size_t)i * DM] = (bf16)f2bf(s / cnt - pin[15 + i]); }
}
__device__ __forceinline__ void ab_unit(int unit, const float* dww, const float* dwb, const float* lng, const float* lnb, const bf16* Z, const bf16* UBp, bf16* Y, LAS unsigned char* lds, int tid, int lane, int wid) {
    const int b = unit >> 6, s0 = (unit & 63) * 64, c = tid & 255, half = tid >> 8, sbase = s0 + 32 * half;
    const size_t tok0 = (size_t)b * SEQ;
    LAS float* cv = (LAS float*)lds;
    const f32x4 g4 = *(const f32x4*)(lng + 4 * lane), b4 = *(const f32x4*)(lnb + 4 * lane);
    float pin[47];
    { float w[CONVW];
#pragma unroll
      for (int j = 0; j < CONVW; ++j) w[j] = dww[j * GW + c];
      const float bias = dwb[c];
      float zin[62];
#pragma unroll
      for (int i = 0; i < 62; ++i) { const int s = sbase - 30 + i; zin[i] = bf2f(Z[(tok0 + (s >= 0 ? s : 0)) * 256 + c]); }
#pragma unroll
      for (int i = 0; i < 47; ++i) { const int s = sbase - 15 + i; pin[i] = bf2f(UBp[(tok0 + (s >= 0 ? s : 0)) * 256 + c]); }
      if (sbase < 30) {
#pragma unroll
          for (int i = 0; i < 62; ++i) zin[i] = (sbase - 30 + i >= 0) ? zin[i] : 0.f; }
#pragma unroll
      for (int i = 0; i < 32; ++i) { float a = bias;
#pragma unroll
          for (int j = 0; j < CONVW; ++j) a += w[j] * zin[i + j];
          cv[(32 * half + i) * 256 + c] = a; } }
    {
      if (sbase < 15) {
#pragma unroll
          for (int i = 0; i < 47; ++i) pin[i] = (sbase - 15 + i >= 0) ? pin[i] : 0.f; }
      bf16* yo = Y + (tok0 + sbase) * DM + 256 + c;
      const int g = (c >> 6);
      if (g == 0) pool_run<2>(pin, sbase, yo); else if (g == 1) pool_run<4>(pin, sbase, yo); else if (g == 2) pool_run<8>(pin, sbase, yo); else pool_run<16>(pin, sbase, yo); }
    __syncthreads();
    {
#pragma unroll
      for (int pp = 0; pp < 8; ++pp) { const int pos = 8 * wid + pp; const f32x4 v = *(const LAS f32x4*)(cv + pos * 256 + 4 * lane);
          const float mu = wave_sum((v.x + v.y) + (v.z + v.w)) * (1.0f / 256.0f); const f32x4 d = v - mu;
          const float var = wave_sum((d.x * d.x + d.y * d.y) + (d.z * d.z + d.w * d.w)) * (1.0f / 256.0f); const float rs = 1.0f / sqrtf(var + 1e-5f);
          f32x4 y = d * rs * g4 + b4; y.x *= pg8::sigm(y.x); y.y *= pg8::sigm(y.y); y.z *= pg8::sigm(y.z); y.w *= pg8::sigm(y.w);
          v2u w; w.x = pg8::cvt_pk_bf16(y.x, y.y); w.y = pg8::cvt_pk_bf16(y.z, y.w);
          *(GAS v2u*)(Y + (tok0 + s0 + pos) * DM + 4 * lane) = w; } }
    __syncthreads();
}

__device__ __forceinline__ void comb_phase(const bf16* OC, const float* LSE, const bf16* OD, bf16* Y, const float* dg, float lam, float omli, int gw, int NGW, int lane) {
    const int h = lane >> 4, d4 = (lane & 15) * 4; const f32x4 g4 = *(const f32x4*)(dg + d4);
    constexpr int U = 4;
    for (int t0 = gw; t0 < T; t0 += U * NGW) {
        float l0[U], l1[U], l2[U]; v2u a[U], bq[U], cq[U];
#pragma unroll
        for (int u = 0; u < U; ++u) { const int t = (t0 + u * NGW < T) ? t0 + u * NGW : t0;
            l0[u] = LSE[(size_t)t * 4 + h]; l1[u] = LSE[((size_t)T + t) * 4 + h]; l2[u] = LSE[((size_t)2 * T + t) * 4 + h];
            a[u] = *(const GAS v2u*)(OC + (size_t)t * 256 + 4 * lane); bq[u] = *(const GAS v2u*)(OC + ((size_t)T + t) * 256 + 4 * lane); cq[u] = *(const GAS v2u*)(OC + ((size_t)2 * T + t) * 256 + 4 * lane); }
#pragma unroll
        for (int u = 0; u < U; ++u) { const int t = t0 + u * NGW; if (t < T) {
            { const float mx = fmaxf(fmaxf(l0[u], l1[u]), l2[u]);
              float w0 = __builtin_amdgcn_exp2f(l0[u] - mx), w1 = __builtin_amdgcn_exp2f(l1[u] - mx), w2 = __builtin_amdgcn_exp2f(l2[u] - mx); const float inv = 1.0f / (w0 + w1 + w2); w0 *= inv; w1 *= inv; w2 *= inv;
              const float y0 = w0 * __uint_as_float(a[u].x << 16) + w1 * __uint_as_float(bq[u].x << 16) + w2 * __uint_as_float(cq[u].x << 16);
              const float y1 = w0 * __uint_as_float(a[u].x & 0xffff0000u) + w1 * __uint_as_float(bq[u].x & 0xffff0000u) + w2 * __uint_as_float(cq[u].x & 0xffff0000u);
              const float y2 = w0 * __uint_as_float(a[u].y << 16) + w1 * __uint_as_float(bq[u].y << 16) + w2 * __uint_as_float(cq[u].y << 16);
              const float y3 = w0 * __uint_as_float(a[u].y & 0xffff0000u) + w1 * __uint_as_float(bq[u].y & 0xffff0000u) + w2 * __uint_as_float(cq[u].y & 0xffff0000u);
              v2u w; w.x = pg8::cvt_pk_bf16(y0, y1); w.y = pg8::cvt_pk_bf16(y2, y3); *(GAS v2u*)(Y + (size_t)t * DM + 512 + 4 * lane) = w; }
} }
    }
}

__device__ __forceinline__ void route_phase(const bf16* x, const float* g2, const float* router, unsigned char* ws, LAS unsigned char* lds, int vcu, int G, int tid, int lane, int wave, size_t dmy = 0, int dmyc = 0) {
    LAS float* rt = (LAS float*)lds; LAS int* cnt = (LAS int*)(lds + 32768); LAS int* base = cnt + 8;
    for (int i = tid; i < NE * DM; i += NWAVES * 64) { const int e = i >> 10, k = i & 1023; rt[i] = g2[k] * router[k * NE + e]; }
    if (tid < NE) cnt[tid] = 0;
    __syncthreads();
    const int gw = vcu * NWAVES + wave, NGW = G * NWAVES;
    int* toke = (int*)(ws + WS_TOKE + dmy); float* tokg = (float*)(ws + WS_TOKG + dmy); int* tokp = (int*)(ws + WS_TOKP + dmy); float* sst = (float*)(ws + WS_SST + dmy);
    constexpr int U = 2;
    v2u nx[U][4];
#pragma unroll
    for (int u = 0; u < U; ++u) { const int t = (gw + u * NGW < T) ? gw + u * NGW : 0; const GAS v2u* xr = (const GAS v2u*)(x + (size_t)t * DM) + lane;
#pragma unroll
        for (int j = 0; j < 4; ++j) nx[u][j] = xr[64 * j]; }
    for (int t0 = gw; t0 < T; t0 += U * NGW) {
        f32x4 xv[U][4]; float ss[U], a[U][NE];
#pragma unroll
        for (int u = 0; u < U; ++u)
#pragma unroll
            for (int j = 0; j < 4; ++j) { const v2u w = nx[u][j]; xv[u][j] = (f32x4){__uint_as_float(w.x << 16), __uint_as_float(w.x & 0xffff0000u), __uint_as_float(w.y << 16), __uint_as_float(w.y & 0xffff0000u)}; }
#pragma unroll
        for (int u = 0; u < U; ++u) { const int tn = t0 + U * NGW + u * NGW; const int t = (tn < T) ? tn : 0; const GAS v2u* xr = (const GAS v2u*)(x + (size_t)t * DM) + lane;
#pragma unroll
            for (int j = 0; j < 4; ++j) nx[u][j] = xr[64 * j]; }
#pragma unroll
        for (int u = 0; u < U; ++u) { ss[u] = 0.f;
#pragma unroll
            for (int e = 0; e < NE; ++e) a[u][e] = 0.f; }
#pragma unroll
        for (int j = 0; j < 4; ++j) {
#pragma unroll
            for (int e = 0; e < NE; ++e) { const f32x4 w = *(const LAS f32x4*)(rt + e * DM + 256 * j + 4 * lane);
#pragma unroll
                for (int u = 0; u < U; ++u) { const f32x4 v = xv[u][j]; a[u][e] += (v.x * w.x + v.y * w.y) + (v.z * w.z + v.w * w.w); } }
#pragma unroll
            for (int u = 0; u < U; ++u) { const f32x4 v = xv[u][j]; ss[u] += (v.x * v.x + v.y * v.y) + (v.z * v.z + v.w * v.w); } }
        float lg[U][NE];
#pragma unroll
        for (int u = 0; u < U; ++u) {
            const bool h5 = (lane & 32) != 0, h4 = (lane & 16) != 0, h3 = (lane & 8) != 0;
            float k4[4], k2[2], k1;
#pragma unroll
            for (int i = 0; i < 4; ++i) { const float send = h5 ? a[u][i] : a[u][4 + i], keep = h5 ? a[u][4 + i] : a[u][i]; k4[i] = keep + __shfl_xor(send, 32); }
#pragma unroll
            for (int i = 0; i < 2; ++i) { const float send = h4 ? k4[i] : k4[2 + i], keep = h4 ? k4[2 + i] : k4[i]; k2[i] = keep + __shfl_xor(send, 16); }
            { const float send = h3 ? k2[0] : k2[1], keep = h3 ? k2[1] : k2[0]; k1 = keep + __shfl_xor(send, 8); }
            k1 += __shfl_xor(k1, 4); k1 += __shfl_xor(k1, 2); k1 += __shfl_xor(k1, 1);
#pragma unroll
            for (int e = 0; e < NE; ++e) lg[u][e] = __builtin_bit_cast(float, __builtin_amdgcn_readlane(__builtin_bit_cast(int, k1), 8 * e));
#pragma unroll
            for (int o = 1; o < 64; o <<= 1) ss[u] += __shfl_xor(ss[u], o);
        }
#pragma unroll
        for (int u = 0; u < U; ++u) { const int t = t0 + u * NGW; if (t < T) {
            const float rs = 1.0f / sqrtf(ss[u] * (1.0f / 1024.0f) + 1e-5f);
            int i0 = 0; float v0 = lg[u][0];
#pragma unroll
            for (int e = 1; e < NE; ++e) if (lg[u][e] > v0) { v0 = lg[u][e]; i0 = e; }
            int i1 = -1; float v1 = -INFINITY;
#pragma unroll
            for (int e = 0; e < NE; ++e) if (e != i0 && lg[u][e] > v1) { v1 = lg[u][e]; i1 = e; }
            const float g0 = 1.0f / (1.0f + expf((v1 - v0) * rs)), g1 = 1.0f - g0;
            if (lane == 0) { const int r0 = __hip_atomic_fetch_add(cnt + i0, 1, __ATOMIC_RELAXED, __HIP_MEMORY_SCOPE_WORKGROUP), r1 = __hip_atomic_fetch_add(cnt + i1, 1, __ATOMIC_RELAXED, __HIP_MEMORY_SCOPE_WORKGROUP);
                toke[2 * t] = i0; toke[2 * t + 1] = i1; tokg[2 * t] = g0; tokg[2 * t + 1] = g1; tokp[2 * t] = r0; tokp[2 * t + 1] = r1; sst[t] = ss[u]; } } }
    }
    VM_WAIT(); __syncthreads();
    if (tid < NE) base[tid] = (int)__hip_atomic_fetch_add((unsigned*)(ws + WS_CTL) + CW_ECNT + dmyc + 64 * tid, (unsigned)cnt[tid], __ATOMIC_RELAXED, __HIP_MEMORY_SCOPE_AGENT);
    __syncthreads();
    { const int t = gw + lane * NGW; if (t < T) { tokp[2 * t] += base[toke[2 * t]]; tokp[2 * t + 1] += base[toke[2 * t + 1]]; } }
    __syncthreads();
}
struct MoeTiles { int ts[9]; };
__device__ __forceinline__ MoeTiles moe_tiles(const unsigned char* ws) {
    MoeTiles m; int acc = 0;
#pragma unroll
    for (int e = 0; e < NE; ++e) { m.ts[e] = acc; const unsigned c = (unsigned)__builtin_amdgcn_readfirstlane((int)__hip_atomic_load((const unsigned*)(ws + WS_CTL) + CW_ECNT + 64 * e, __ATOMIC_RELAXED, __HIP_MEMORY_SCOPE_AGENT)); acc += (int)((c + 255u) >> 8); }
    m.ts[8] = acc; return m;
}
__device__ __forceinline__ void gather_phase(unsigned char* ws, int gw, int NGW, int lane) {
    const MoeTiles mt = moe_tiles(ws);
    const int* toke = (const int*)(ws + WS_TOKE); int* tokp = (int*)(ws + WS_TOKP); const float* sst = (const float*)(ws + WS_SST); float* ssrow = (float*)(ws + WS_SSROW);
    const unsigned char* xb = ws + WS_XB8; unsigned char* hs = ws + WS_HS;
    constexpr int U = 4;
    for (int t0 = gw; t0 < T; t0 += U * NGW) {
        int p0[U], p1[U]; v4u a[U]; float s[U];
#pragma unroll
        for (int u = 0; u < U; ++u) { const int t = (t0 + u * NGW < T) ? t0 + u * NGW : t0; const int e0 = toke[2 * t], e1 = toke[2 * t + 1];
            int o0 = 0, o1 = 0;
#pragma unroll
            for (int e = 0; e < NE; ++e) { if (e == e0) o0 = mt.ts[e]; if (e == e1) o1 = mt.ts[e]; }
            p0[u] = o0 * 256 + tokp[2 * t]; p1[u] = o1 * 256 + tokp[2 * t + 1]; s[u] = sst[t];
            a[u] = __builtin_nontemporal_load((const GAS v4u*)(xb + (size_t)t * DM) + lane); }
#pragma unroll
        for (int u = 0; u < U; ++u) { const int t = t0 + u * NGW; if (t < T) {
            *((GAS v4u*)(hs + (size_t)p0[u] * DM) + lane) = a[u]; *((GAS v4u*)(hs + (size_t)p1[u] * DM) + lane) = a[u];
            if (lane == 0) { ssrow[p0[u]] = s[u]; ssrow[p1[u]] = s[u]; tokp[2 * t] = p0[u]; tokp[2 * t + 1] = p1[u]; } } }
    }
}
__device__ __forceinline__ void final_phase(float* xo, const bf16* xres, const float* fg, const unsigned char* ws, int gw, int NGW, int lane, float* dst = nullptr) {
    const int* tokp = (const int*)(ws + WS_TOKP); const float* tokg = (const float*)(ws + WS_TOKG); const unsigned char* y2 = ws + WS_Y2;
    constexpr int U = 4;
    for (int t0 = gw; t0 < T; t0 += U * NGW) {
        f32x4 xv[U][4]; unsigned ya[U][4], yb[U][4]; float g0[U], g1[U];
#pragma unroll
        for (int u = 0; u < U; ++u) { const int t = (t0 + u * NGW < T) ? t0 + u * NGW : t0; const int p0 = tokp[2 * t], p1 = tokp[2 * t + 1]; g0[u] = tokg[2 * t]; g1[u] = tokg[2 * t + 1];
            const GAS v2u* xr = (const GAS v2u*)(xres + (size_t)t * DM) + lane; const GAS unsigned* pa = (const GAS unsigned*)(y2 + (size_t)p0 * DM) + lane; const GAS unsigned* pb = (const GAS unsigned*)(y2 + (size_t)p1 * DM) + lane;
#pragma unroll
            for (int j = 0; j < 4; ++j) { const v2u w = xr[64 * j]; xv[u][j] = (f32x4){__uint_as_float(w.x << 16), __uint_as_float(w.x & 0xffff0000u), __uint_as_float(w.y << 16), __uint_as_float(w.y & 0xffff0000u)}; ya[u][j] = __builtin_nontemporal_load(pa + 64 * j); yb[u][j] = __builtin_nontemporal_load(pb + 64 * j); } }
#pragma unroll
        for (int u = 0; u < U; ++u) { const int t = t0 + u * NGW; if (t < T) {
            f32x4 v[4]; float ss = 0.f;
#pragma unroll
            for (int j = 0; j < 4; ++j) { typedef float f2_t __attribute__((ext_vector_type(2)));
                const f2_t a01 = __builtin_amdgcn_cvt_pk_f32_fp8((int)ya[u][j], false), a23 = __builtin_amdgcn_cvt_pk_f32_fp8((int)ya[u][j], true), c01 = __builtin_amdgcn_cvt_pk_f32_fp8((int)yb[u][j], false), c23 = __builtin_amdgcn_cvt_pk_f32_fp8((int)yb[u][j], true);
                const float h0 = g0[u] * (1.0f / pg8::Y_SCALE), h1 = g1[u] * (1.0f / pg8::Y_SCALE);
                v[j].x = xv[u][j].x + h0 * a01.x + h1 * c01.x; v[j].y = xv[u][j].y + h0 * a01.y + h1 * c01.y; v[j].z = xv[u][j].z + h0 * a23.x + h1 * c23.x; v[j].w = xv[u][j].w + h0 * a23.y + h1 * c23.y;
                ss += (v[j].x * v[j].x + v[j].y * v[j].y) + (v[j].z * v[j].z + v[j].w * v[j].w); }
            ss = wave_sum(ss); const float rs = 1.0f / sqrtf(ss * (1.0f / 1024.0f) + 1e-5f);
            GAS f32x4* orow = (GAS f32x4*)((dst ? dst : xo) + (size_t)t * DM) + lane;
#pragma unroll
            for (int j = 0; j < 4; ++j) { const f32x4 g = *(const f32x4*)(fg + 256 * j + 4 * lane); __builtin_nontemporal_store(v[j] * rs * g, orow + 64 * j); } } }
    }
}
__device__ __forceinline__ unsigned char* opq(unsigned char* p) { asm volatile("" : "+s"(p)); return p; }
struct Args { const float* in[22]; float* out; unsigned char* ws; int ph_lo, ph_hi; };
#ifndef PHASE_MASK
#define PHASE_MASK 0xFFFFFFFFull
#endif
#ifndef MIX_MASK
#define MIX_MASK 7
#endif
__global__ void __launch_bounds__(NWAVES * 64, 2) hymba_fwd(Args args) {
    extern __shared__ __attribute__((aligned(16))) unsigned char lds_raw[];
    LAS unsigned char* lds = (LAS unsigned char*)lds_raw;
    volatile LAS unsigned* MISC = (volatile LAS unsigned*)(lds + MISC_OFF);
    for (int u = threadIdx.x; u < (LDS_BYTES - LDSCTL_OFF) / 4; u += NWAVES * 64) ((LAS unsigned*)(lds + LDSCTL_OFF))[u] = 0u;
    __syncthreads();
    if (threadIdx.x == 0) {
#pragma unroll
        for (int i = 0; i < 22; ++i) ((LAS unsigned long long*)(lds + LDSCTL_OFF))[i] = (unsigned long long)args.in[i];
        ((LAS unsigned long long*)(lds + LDSCTL_OFF))[22] = (unsigned long long)args.out; ((LAS unsigned long long*)(lds + LDSCTL_OFF))[23] = (unsigned long long)args.ws;
    }
    __syncthreads();
    XcdBarrier bar; bar.bar = nullptr; bar.x = 0; bar.st = MISC + 8;
    if (!MK_PER_PHASE) bar = xcd_barrier_post((unsigned*)((unsigned char*)inp(lds, 23) + WS_CTL) + CW_BAR, MISC + 8);
    MISC[10] = bar.x;
#ifdef PROBE_PT
    if (threadIdx.x == 0) *(volatile LAS unsigned long long*)(MISC + 16) = __builtin_amdgcn_s_memrealtime();
#endif
#if MK_PER_PHASE
    MISC[11] = (unsigned)args.ph_lo; MISC[12] = (unsigned)args.ph_hi;
#define IN(k) (((PHASE_MASK >> (k)) & 1ull) && (int)MISC[11] <= (k) && (k) < (int)MISC[12])
#define SEAM(k) do { } while (0)
#else
#define IN(k) ((PHASE_MASK >> (k)) & 1ull)
#ifdef PROBE_WAIT
#define SEAM_T0(k) unsigned long long t0_ = 0; if (((PROBE_WAIT) >> (k)) & 1ull) t0_ = __builtin_amdgcn_s_memrealtime();
#define SEAM_T1(k) if ((((PROBE_WAIT) >> (k)) & 1ull) && threadIdx.x == 0) MISC[13] = MISC[13] + (unsigned)(__builtin_amdgcn_s_memrealtime() - t0_);
#elif defined(PROBE_PT)
#define SEAM_T0(k) if (((PROBE_PT) >> (k)) & 1ull) __syncthreads(); if ((((PROBE_PT) >> (k)) & 1ull) && threadIdx.x == 0) { const unsigned long long nw_ = __builtin_amdgcn_s_memrealtime(), st_ = *(volatile LAS unsigned long long*)(MISC + 16), dl_ = (unsigned long long)(PROBE_K) * (nw_ - st_); \
        while (__builtin_amdgcn_s_memrealtime() - nw_ < dl_) __builtin_amdgcn_s_sleep(8); }
#define SEAM_T1(k) if (threadIdx.x == 0) *(volatile LAS unsigned long long*)(MISC + 16) = __builtin_amdgcn_s_memrealtime();
#else
#define SEAM_T0(k)
#define SEAM_T1(k)
#endif
#define SEAM(k) do { SEAM_T0(k) for (int sr_ = 0; sr_ < DUPN(45); ++sr_) { XcdBarrier b2_; b2_.bar = (unsigned*)((unsigned char*)inp(lds, 23) + WS_CTL) + CW_BAR; b2_.x = __builtin_amdgcn_readfirstlane(MISC[10]); b2_.st = MISC + 8; xcd_barrier(b2_); } SEAM_T1(k) } while (0)
#endif
#define PHASE_CTX \
    int tid = threadIdx.x; asm volatile("" : "+v"(tid)); const int lane = tid & 63, wave = __builtin_amdgcn_readfirstlane(tid >> 6); \
    int G = gridDim.x, bx = blockIdx.x; asm volatile("" : "+s"(G), "+s"(bx)); const int vcu = (G % 8 == 0) ? (bx % 8) * (G / 8) + bx / 8 : bx; \
    const int gw = vcu * NWAVES + wave, NGW = G * NWAVES; \
    unsigned char* const ws = (unsigned char*)inp(lds, 23); float* const xo = (float*)inp(lds, 22); \
    bf16* XB = (bf16*)(ws + WS_XB); bf16* UB = (bf16*)(ws + WS_UB); bf16* QD = (bf16*)(ws + WS_QD); bf16* Y = (bf16*)(ws + WS_Y); bf16* OC = (bf16*)(ws + WS_OC); float* LSE = (float*)(ws + WS_LSE); \
    (void)lane; (void)wave; (void)vcu; (void)gw; (void)NGW; (void)xo; (void)XB; (void)UB; (void)QD; (void)Y; (void)OC; (void)LSE;

    if (IN(0)) for (int rep_ = 0; rep_ < DUPN(0); ++rep_) { PHASE_CTX p0_prologue(ws, lds, vcu, G, tid, lane, wave); }
    SEAM(0);

#define LAYER_COMMON(l, pb) \
    if (IN(pb)) for (int rep_ = 0; rep_ < DUPN(pb); ++rep_) { PHASE_CTX \
        pg8::Gemm g{XB, (const bf16*)(ws + WS_WIN + (l) * SZ_WIN), T, NIN, DM}; pg8::StaticOrder S; S.init(T, NIN, G, bx); \
        pg8::EpiIn<(l) != 0> E{(const float*)(ws + ((l) == 0 ? WS_SS0 : WS_SSP)), UB, QD, (const float*)(ws + WS_ROPEC), (const float*)(ws + WS_ROPED), (size_t)T * 256}; \
        if ((l) == 0 && (bx & 1)) { tr_share(ws, lds, bx, G, wave, lane); __syncthreads(); }     \
        pg8::gemm_phase<pg8::EpiIn<(l) != 0>, pg8::StaticOrder, true, true>(lds + RING_OFF, g, S, E); \
        if ((l) == 0 && !(bx & 1)) { tr_share(ws, lds, bx, G, wave, lane); } \
    } \
    SEAM(pb); \
    if (IN((pb) + 1)) { \
        if (MIX_MASK & 1) for (int rep_ = DUPN(40) - 1; rep_ >= 0; --rep_) { PHASE_CTX \
          const bf16* KD = UB + (size_t)5 * T * 256; const bf16* VD = UB + (size_t)6 * T * 256; \
          const float* mi_ = (const float*)(ws + WS_MISC); const float lam_ = mi_[2 * (l)], omli_ = mi_[2 * (l) + 1]; const float* dg_ = IN_(11) + (l) * 64; \
          for (int i = 0; ; ++i) {                                    \
            int pair, qb; \
            if (G == 256) { if (i >= 2) break; const int s = vcu & 7; pair = vcu >> 3; qb = (i == 0) ? s : 15 - s; } \
            else { const int id = i * G + vcu; if (id >= 512) break; pair = id >> 4; qb = id & 15; } \
            attn_body::attn_unit<8, 1>(pair >> 2, 2 * (pair & 3), qb, (const attn_body::bf16*)QD, (const attn_body::bf16*)KD, (const attn_body::bf16*)VD, nullptr, (char*)lds_raw + RING_OFF); \
            attn_body::attn_unit<8, 2>(pair >> 2, 2 * (pair & 3) + 1, qb, (const attn_body::bf16*)QD, (const attn_body::bf16*)KD, (const attn_body::bf16*)VD, (attn_body::bf16*)(Y + 768), (char*)lds_raw + RING_OFF, lam_, omli_, dg_); \
          } \
          __syncthreads(); } \
        if (MIX_MASK & 2) for (int rep_ = 0; rep_ < DUPN(41); ++rep_) { PHASE_CTX v4u kr_[6], vr_[6]; const bf16* QC_ = UB + (size_t)2 * T * 256; const bf16* KC_ = UB + (size_t)3 * T * 256; const bf16* VC_ = UB + (size_t)4 * T * 256; \
          if (vcu < 1536) dil_load(vcu, KC_, VC_, tid, kr_, vr_); \
          for (int uc = vcu; uc < 1536; uc += G) { bf16x8 qr_[4]; dil_loadq(uc, QC_, lane, wave, qr_); dil_stage(uc, kr_, vr_, lds + RING_OFF, tid); __syncthreads(); dil_compute(uc, qr_, OC, LSE, lds + RING_OFF, lane, wave, (uc + G < 1536) ? uc + G : -1, KC_, VC_, tid, kr_, vr_); } } \
        if (MIX_MASK & 4) for (int rep_ = 0; rep_ < DUPN(42); ++rep_) { PHASE_CTX for (int un = vcu; un < 512; un += G) ab_unit(un, IN_(3) + (l) * CONVW * GW, IN_(4) + (l) * GW, IN_(5) + (l) * GW, IN_(6) + (l) * GW, UB, UB + (size_t)T * 256, Y, lds + RING_OFF, tid, lane, wave); } \
    } \
    SEAM((pb) + 1); \
    if (IN((pb) + 2)) for (int rep_ = 0; rep_ < DUPN((pb) + 2); ++rep_) { PHASE_CTX const float* mi = (const float*)(ws + WS_MISC); comb_phase(OC, LSE, QD, Y, IN_(11) + (l) * 64, mi[2 * (l)], mi[2 * (l) + 1], gw, NGW, lane); } \
    SEAM((pb) + 2); \
    if (IN((pb) + 3)) for (int rep_ = 0; rep_ < ((l) == 0 ? DUPN(4) : 1); ++rep_) { PHASE_CTX \
        pg8::Gemm g{Y, (const bf16*)(ws + WS_WOUT + (l) * SZ_WOUT), T, DM, DM}; pg8::StaticOrder S; S.init(T, DM, G, bx); \
        pg8::EpiRes<(l) == 0, (l) != 0, (l) == 0> E{IN_(0), XB, ws + WS_XB8, (float*)(ws + WS_SSP), 1.0f}; pg8::gemm_phase<pg8::EpiRes<(l) == 0, (l) != 0, (l) == 0>, pg8::StaticOrder, true, true>(lds + RING_OFF, g, S, E); \
    } \
    SEAM((pb) + 3);

    LAYER_COMMON(0, 1)
    if (IN(5)) for (int rep_ = 0; rep_ < DUPN(5); ++rep_) { PHASE_CTX
        pg8::Gemm g{XB, (const bf16*)(ws + WS_W1), T, 2 * DFF, DM}; pg8::StaticOrder S; S.init(T, 2 * DFF, G, bx);
        pg8::EpiGlu<true, false> E{ws + WS_HID, DFF, (const float*)(ws + WS_SSP), 0};
        pg8::gemm_phase<pg8::EpiGlu<true, false>, pg8::StaticOrder, true, true>(lds + RING_OFF, g, S, E);
    }
    SEAM(5);
    if (IN(6)) { PHASE_CTX
        pg8::Gemm g{(const bf16*)(ws + WS_HID), (const bf16*)(ws + WS_W2), T, DM, DFF}; pg8::StaticOrder S; S.init(T, DM, G, bx);
        pg8::EpiRes<true, false, false> E{nullptr, XB, nullptr, (float*)(ws + WS_SSP), 1.0f};
        pg8::gemm_phase<pg8::EpiRes<true, false, false>, pg8::StaticOrder, true, true>(lds + RING_OFF, g, S, E);
    }
    SEAM(6);
    LAYER_COMMON(1, 7)
#undef LAYER_COMMON
    if (IN(11) && DUPN(43) > 1) { PHASE_CTX route_phase(XB, IN_(13) + DM, IN_(17), ws, lds + RING_OFF, vcu, G, tid, lane, wave, WS_HIDE - WS_TOKE, 1024); }
    if (IN(11)) { PHASE_CTX route_phase(XB, IN_(13) + DM, IN_(17), ws, lds + RING_OFF, vcu, G, tid, lane, wave); }
    SEAM(11);
    if (IN(12)) for (int rep_ = 0; rep_ < DUPN(12); ++rep_) { PHASE_CTX gather_phase(ws, gw, NGW, lane); }
    SEAM(12);
#define MOE_SETUP(kk) const MoeTiles mt = moe_tiles(ws); const int nt_ = mt.ts[8], nfull_ = nt_ / MOE_CHUNK_TILES, rem_ = nt_ - nfull_ * MOE_CHUNK_TILES; \
        const int t0_ = (kk) == 0 ? 0 : rem_ + MOE_CHUNK_TILES * ((kk) - 1); int nm_ = (kk) == 0 ? rem_ : ((kk) <= nfull_ ? MOE_CHUNK_TILES : 0);
#define MOE_TS(S) S.ts1 = mt.ts[1]; S.ts2 = mt.ts[2]; S.ts3 = mt.ts[3]; S.ts4 = mt.ts[4]; S.ts5 = mt.ts[5]; S.ts6 = mt.ts[6]; S.ts7 = mt.ts[7];
#define MOE_PHASE(k) \
    if (IN(13 + (k))) { \
        int lev_r_ = 0; \
        if ((k) >= 1) for (int rep_ = 0; rep_ < DUPN(13 + (k)); ++rep_) { PHASE_CTX MOE_SETUP((k) - 1) \
            pg8::Gemm g{(const bf16*)(ws + WS_HIDE + (((k) - 1) & 1) * SZ_HIDE), (const bf16*)(ws + WS_W2E), nm_ * 256, DM, DFE / 2}; \
            pg8::MoeOrder S; S.init(nm_ * 256, DM, G, bx); S.tile0 = t0_; S.a_off = t0_; MOE_TS(S) S.estride = SZ_W2E; S.lev_r = 0; S.lev_d = 0; lev_r_ = (nm_ * 4) % G; \
            pg8::EpiY E{ws + WS_Y2}; \
            pg8::gemm_phase<pg8::EpiY, pg8::MoeOrder, true, true, true>(lds + RING_OFF, g, S, E); } \
        if ((k) <= 4) { PHASE_CTX MOE_SETUP(k) \
            pg8::Gemm g{(const bf16*)(ws + WS_HS), (const bf16*)(ws + WS_W1E), nm_ * 256, 2 * DFE, DM / 2}; \
            pg8::MoeOrder S; S.init(nm_ * 256, 2 * DFE, G, bx); S.tile0 = t0_; S.a_off = 0; MOE_TS(S) S.estride = SZ_W1E; S.lev_r = lev_r_; S.lev_d = (lev_r_ > 0 && (long)(G - lev_r_) * 3 <= (long)nm_ * 28) ? 3 : 0; \
            pg8::EpiGlu<false, true> E{ws + WS_HIDE + ((k) & 1) * SZ_HIDE, DFE, (const float*)(ws + WS_SSROW), t0_}; \
            pg8::gemm_phase<pg8::EpiGlu<false, true>, pg8::MoeOrder, true, true, true>(lds + RING_OFF, g, S, E); } \
    } \
    SEAM(13 + (k));
    MOE_PHASE(0) MOE_PHASE(1) MOE_PHASE(2) MOE_PHASE(3) MOE_PHASE(4) MOE_PHASE(5)
#undef MOE_PHASE
#undef MOE_SETUP
#undef MOE_TS
    if (IN(N_PHASES - 1) && DUPN(44) > 1) { PHASE_CTX final_phase(xo, XB, IN_(21), ws, gw, NGW, lane, (float*)(ws + WS_HIDE)); }
    if (IN(N_PHASES - 1)) { PHASE_CTX final_phase(xo, XB, IN_(21), ws, gw, NGW, lane); }
#ifdef PROBE_PT
    { __syncthreads(); SEAM_T0(N_PHASES - 1) __syncthreads(); }
#endif
#ifdef PROBE_WAIT
    {
        __syncthreads();
        unsigned* pw_ = (unsigned*)((unsigned char*)inp(lds, 23) + WS_CTL) + 12288;
        if (threadIdx.x == 0) atomicAdd(pw_, MISC[13]);
        SEAM(63);
        if (threadIdx.x == 0) { const unsigned sum_ = __hip_atomic_load(pw_, __ATOMIC_RELAXED, __HIP_MEMORY_SCOPE_AGENT); const unsigned long long dl_ = (unsigned long long)(PROBE_K) * (sum_ / gridDim.x);
            const unsigned long long ts_ = __builtin_amdgcn_s_memrealtime(); while (__builtin_amdgcn_s_memrealtime() - ts_ < dl_) __builtin_amdgcn_s_sleep(8); }
        __syncthreads();
    }
#endif
#undef IN
#undef SEAM
#undef PHASE_CTX
}

extern "C" void kernel_launch(void* const* d_in, const int* in_sizes, int n_in, void* d_out, int out_size, void* d_ws, size_t ws_size, hipStream_t stream) {
    static int grid = 0;
    if (grid == 0) {
        if (n_in != 22 || in_sizes[0] != T * DM || out_size != T * DM || ws_size < WS_END) { fprintf(stderr, "kernel_launch: unexpected shapes (n_in %d, ws %zu, need %zu); nothing launched\n", n_in, ws_size, (size_t)WS_END); grid = -1; return; }
        int dev = 0, cus = 0;
        if (hipGetDevice(&dev) != hipSuccess || hipDeviceGetAttribute(&cus, hipDeviceAttributeMultiprocessorCount, dev) != hipSuccess) { grid = -1; return; }
        if (hipFuncSetAttribute((const void*)hymba_fwd, hipFuncAttributeMaxDynamicSharedMemorySize, LDS_BYTES) != hipSuccess) { fprintf(stderr, "kernel_launch: hipFuncSetAttribute failed\n"); grid = -1; return; }
        int per_cu = 0;
        if (hipOccupancyMaxActiveBlocksPerMultiprocessor(&per_cu, (const void*)hymba_fwd, NWAVES * 64, LDS_BYTES) != hipSuccess || per_cu < 1) fprintf(stderr, "kernel_launch: note: occupancy query reports %d\n", per_cu);
        (void)hipGetLastError();
        grid = cus;
    }
    if (grid < 0) return;
    if (hipMemsetAsync((char*)d_ws + WS_CTL, 0, CTL_ZERO_BYTES, stream) != hipSuccess) return;
    Args a{};
    for (int i = 0; i < 22; ++i) a.in[i] = (const float*)d_in[i];
    a.out = (float*)d_out; a.ws = (unsigned char*)d_ws;
#if MK_PER_PHASE
    for (int p = 0; p < N_PHASES; ++p) { a.ph_lo = p; a.ph_hi = p + 1; hipLaunchKernelGGL(hymba_fwd, dim3(grid), dim3(NWAVES * 64), LDS_BYTES, stream, a); }
#else
    a.ph_lo = 0; a.ph_hi = N_PHASES;
    hipLaunchKernelGGL(hymba_fwd, dim3(grid), dim3(NWAVES * 64), LDS_BYTES, stream, a);
#endif
}
```

```cpp
#include <hip/hip_runtime.h>
#include <hip/hip_bf16.h>
#include <cstdio>
#include <cstdint>
#include <cmath>
namespace pg8 {
#define PG8_LAS __attribute__((address_space(3)))
typedef unsigned short bf16_t;
typedef short bf16x8 __attribute__((ext_vector_type(8)));
typedef float f32x4 __attribute__((ext_vector_type(4)));
typedef unsigned u32x4 __attribute__((ext_vector_type(4)));
typedef unsigned u32x2 __attribute__((ext_vector_type(2)));
constexpr int BM = 256, BK = 64, HALF = 128, HTB = HALF * BK * 2  , STAGE_BYTES = 8 * HTB, NXCD = 8, WGM = 8;

__host__ __device__ __forceinline__ int lds_byte(int r, int c) { const int st = (r >> 4) * 2 + (c >> 5), rr = r & 15, cc = c & 31, ob = rr * 64 + cc * 2; return st * 1024 + (ob ^ (((ob >> 9) & 1) << 5)); }
__host__ __device__ __forceinline__ void stage_rc(int b, int& R, int& C) { const int st = b / 1024, sb = b % 1024, swz = sb ^ (((sb >> 9) & 1) << 5); R = (st >> 1) * 16 + swz / 64; C = (st & 1) * 32 + (swz % 64) / 2; }
__host__ __device__ __forceinline__ int perm32(int rho) { const int n = rho >> 4, i = rho & 15; return 8 * (i >> 2) + 4 * n + (i & 3); }

struct Unit { int pm, pn; };
struct Gemm { const bf16_t* A; const bf16_t* Bt; int M, N, K; };

struct StaticOrder {
    int nM, nN, nwg, G, c;
    __host__ __device__ void init(int M, int N, int G_, int c_) { nM = M / BM; nN = N / BM; nwg = nM * nN; G = G_; c = c_; }
    __host__ __device__ bool next(int i, Unit& u) const {
        const long L = (long)i * G + c; if (L >= nwg) return false;
        int wgid = (int)L; { const int q = nwg / NXCD, r = nwg % NXCD, xcd = wgid % NXCD, off = wgid / NXCD; wgid = (xcd < r ? xcd * (q + 1) : r * (q + 1) + (xcd - r) * q) + off; }
        const int nig = WGM * nN, gid = wgid / nig, fm = gid * WGM, gsz = (nM - fm) < WGM ? (nM - fm) : WGM;
        u.pm = fm + ((wgid % nig) % gsz); u.pn = (wgid % nig) / gsz; return true;
    }
    __device__ __forceinline__ const char* a_ptr(const Gemm& g, const Unit& u) const { return (const char*)g.A + (size_t)u.pm * ((size_t)BM * g.K * 2); }
    __device__ __forceinline__ const char* b_ptr(const Gemm& g, const Unit& u) const { return (const char*)g.Bt + (size_t)u.pn * ((size_t)BM * g.K * 2); }
    __device__ __forceinline__ void a_ready(const Unit&) const {}
    __device__ __forceinline__ void done(const Unit&) const {}
};
struct MoeOrder : StaticOrder {
    int tile0, a_off; int ts1, ts2, ts3, ts4, ts5, ts6, ts7; size_t estride;
    int lev_r, lev_d;
    __device__ __forceinline__ bool next(int i, Unit& u) const {
        long L;
        if (lev_d == 0) L = (long)i * G + c;
        else { const long E = (long)(G - lev_r) * lev_d; L = (c >= lev_r) ? ((i < lev_d) ? (long)(c - lev_r) * lev_d + i : E + (long)(i - lev_d) * G + c) : E + (long)i * G + c; }
        if (L >= nwg) return false;
        int wgid = (int)L; { const int q = nwg / NXCD, r = nwg % NXCD, xcd = wgid % NXCD, off = wgid / NXCD; wgid = (xcd < r ? xcd * (q + 1) : r * (q + 1) + (xcd - r) * q) + off; }
        const int nig = WGM * nN, gid = wgid / nig, fm = gid * WGM, gsz = (nM - fm) < WGM ? (nM - fm) : WGM;
        u.pm = fm + ((wgid % nig) % gsz) + tile0; u.pn = (wgid % nig) / gsz; return true;
    }
    __device__ __forceinline__ int expert(int pm) const { return (pm >= ts1) + (pm >= ts2) + (pm >= ts3) + (pm >= ts4) + (pm >= ts5) + (pm >= ts6) + (pm >= ts7); }
    __device__ __forceinline__ const char* a_ptr(const Gemm& g, const Unit& u) const { return (const char*)g.A + (size_t)(u.pm - a_off) * ((size_t)BM * g.K * 2); }
    __device__ __forceinline__ const char* b_ptr(const Gemm& g, const Unit& u) const { return (const char*)g.Bt + (size_t)expert(u.pm) * estride + (size_t)u.pn * ((size_t)BM * g.K * 2); }
};

__device__ __forceinline__ unsigned cvt_pk_bf16(float lo, float hi) { unsigned r; asm volatile("v_cvt_pk_bf16_f32 %0, %1, %2" : "=v"(r) : "v"(lo), "v"(hi)); return r; }
__device__ __forceinline__ u32x4 pack8(const f32x4 v0, const f32x4 v1) { u32x4 w; w.x = cvt_pk_bf16(v0[0], v0[1]); w.y = cvt_pk_bf16(v0[2], v0[3]); w.z = cvt_pk_bf16(v1[0], v1[1]); w.w = cvt_pk_bf16(v1[2], v1[3]); return w; }
__device__ __forceinline__ float sigm(float b) { return __builtin_amdgcn_rcpf(1.0f + __builtin_amdgcn_exp2f(-1.4426950408889634f * b)); }
constexpr float RMS_EPS = 1e-5f;
constexpr float F8_ACT = 8.0f, F8_WGT = 64.0f, F8_INV = 1.0f / 512.0f, Y_SCALE = 16.0f;
__device__ __forceinline__ float clamp8(float v) { return __builtin_fminf(__builtin_fmaxf(v, -448.0f), 448.0f); }
__device__ __forceinline__ unsigned pack4_fp8(float a, float b, float c, float d) {
    int w = __builtin_amdgcn_cvt_pk_fp8_f32(__builtin_amdgcn_fmed3f(a, -448.0f, 448.0f), __builtin_amdgcn_fmed3f(b, -448.0f, 448.0f), 0, false);
    w = __builtin_amdgcn_cvt_pk_fp8_f32(__builtin_amdgcn_fmed3f(c, -448.0f, 448.0f), __builtin_amdgcn_fmed3f(d, -448.0f, 448.0f), w, true); return (unsigned)w; }

constexpr float SCALE_C = 0.125f * 1.4426950408889634f;
constexpr float SCALE_D = 0.17677669529663687f * 1.4426950408889634f;

__device__ __forceinline__ void st16_rowpair(u32x2 a, u32x2 b, unsigned char* p) {
    asm volatile("s_nop 1" : "+v"(a.x), "+v"(a.y), "+v"(b.x), "+v"(b.y));
    const auto r0 = __builtin_amdgcn_permlane16_swap(a.x, b.x, false, false); const auto r1 = __builtin_amdgcn_permlane16_swap(a.y, b.y, false, false);
    *(u32x4*)p = (u32x4){r0[0], r1[0], r0[1], r1[1]};
}
template <bool PARTS> __device__ __forceinline__ f32x4 rsum_ld(const float* ss, int row, int fq) {
    if (!PARTS) { const float v = ss[row]; return (f32x4){v, 0.f, 0.f, 0.f}; }
    return *((const f32x4*)(ss + (size_t)row * 16) + fq);
}
template <bool PARTS> __device__ __forceinline__ float rsum_fin(const f32x4 a) {
    if (!PARTS) return a[0];
    const float q = (a[0] + a[1]) + (a[2] + a[3]);
    const auto r = __builtin_amdgcn_permlane16_swap(__float_as_uint(q), __float_as_uint(q), false, false); const float h = __uint_as_float(r[0]) + __uint_as_float(r[1]);
    const auto t = __builtin_amdgcn_permlane32_swap(__float_as_uint(h), __float_as_uint(h), false, false); return __uint_as_float(t[0]) + __uint_as_float(t[1]);
}
template <bool PARTS> struct EpiIn {
    static constexpr bool PERM = true, AFTER_DRAIN = false;
    const float* ss; bf16_t* ub; bf16_t* qd; const float* ropeC; const float* ropeD; size_t bstride;
    __device__ __forceinline__ void operator()(const f32x4 (&acc)[2][2][4][2], const Unit& u, int wr, int wc, int fr, int fq) const {
        asm volatile("" : "+v"(fr), "+v"(fq));
        const int pn = u.pn, row0 = u.pm * BM + wr * 64 + fr, cl = wc * 32 + 8 * fq;
        float rsv[2][4];
        { f32x4 rq[2][4];
#pragma unroll
          for (int ai = 0; ai < 2; ++ai)
#pragma unroll
              for (int m = 0; m < 4; ++m) rq[ai][m] = rsum_ld<PARTS>(ss, row0 + ai * HALF + m * 16, fq);
#pragma unroll
          for (int ai = 0; ai < 2; ++ai)
#pragma unroll
              for (int m = 0; m < 4; ++m) rsv[ai][m] = __builtin_amdgcn_rsqf(rsum_fin<PARTS>(rq[ai][m]) * (1.0f / 1024.0f) + RMS_EPS); }
        if (pn < 2) {
            bf16_t* Z = ub + (size_t)pn * HALF + cl;
#pragma unroll
            for (int ai = 0; ai < 2; ++ai)
#pragma unroll
                for (int m = 0; m < 4; ++m) { const int row = row0 + ai * HALF + m * 16; const float rs = rsv[ai][m];
                    f32x4 z0, z1;
                    { const float rsn = rs * -1.4426950408889634f; f32x4 e0 = acc[ai][1][m][0] * rsn, e1 = acc[ai][1][m][1] * rsn;
#pragma unroll
                      for (int j = 0; j < 4; ++j) { e0[j] = __builtin_amdgcn_exp2f(e0[j]); e1[j] = __builtin_amdgcn_exp2f(e1[j]); }
                      e0 = e0 + 1.0f; e1 = e1 + 1.0f;
#pragma unroll
                      for (int j = 0; j < 4; ++j) { e0[j] = __builtin_amdgcn_rcpf(e0[j]); e1[j] = __builtin_amdgcn_rcpf(e1[j]); }
                      z0 = (acc[ai][0][m][0] * rs) * e0; z1 = (acc[ai][0][m][1] * rs) * e1; }
                    *(u32x4*)(Z + (size_t)row * 256) = pack8(z0, z1); asm volatile("" ::: "memory"); }
        } else if (pn == 2 || pn == 5 || pn == 8) {
            bf16_t* O = ub + (size_t)(pn == 2 ? 1 : (pn == 5 ? 4 : 6)) * bstride + cl;
#pragma unroll
            for (int ai = 0; ai < 2; ++ai)
#pragma unroll
                for (int m = 0; m < 4; ++m) { const int row = row0 + ai * HALF + m * 16; const float rs = rsv[ai][m];
#pragma unroll
                    for (int bj = 0; bj < 2; ++bj) *(u32x4*)(O + (size_t)row * 256 + bj * HALF) = pack8(acc[ai][bj][m][0] * rs, acc[ai][bj][m][1] * rs);
                    asm volatile("" ::: "memory"); }
        } else if (pn < 5) {
            bf16_t* O = ub + (size_t)(pn - 1) * bstride + cl; const float sc = (pn == 3) ? SCALE_C : 1.0f;
            const bool rotw = (wc & 1) == 0; const bool rotl = fq < 2;
#pragma unroll
            for (int ai = 0; ai < 2; ++ai)
#pragma unroll
                for (int m = 0; m < 4; ++m) { const int row = row0 + ai * HALF + m * 16; const float rs = rsv[ai][m];
                    f32x4 cs = (f32x4){1.f, 1.f, 1.f, 1.f}, sn = (f32x4){0.f, 0.f, 0.f, 0.f};
                    if (rotw) { const float* tp = ropeC + (size_t)(row & 4095) * 16 + (fq & 1) * 8; const f32x4 c4 = *(const f32x4*)tp, s4 = *(const f32x4*)(tp + 4); if (rotl) { cs = c4; sn = s4; } }
#pragma unroll
                    for (int bj = 0; bj < 2; ++bj) { const f32x4 x1 = acc[ai][bj][m][0] * rs, x2 = acc[ai][bj][m][1] * rs;
                        *(u32x4*)(O + (size_t)row * 256 + bj * HALF) = pack8((x1 * cs - x2 * sn) * sc, (x2 * cs + x1 * sn) * sc); }
                    asm volatile("" ::: "memory"); }
        } else {
            const bool rotl = fq == 0;
#pragma unroll
            for (int ai = 0; ai < 2; ++ai)
#pragma unroll
                for (int m = 0; m < 4; ++m) { const int row = row0 + ai * HALF + m * 16; const float rs = rsv[ai][m];
                    f32x4 cs = (f32x4){1.f, 1.f, 1.f, 1.f}, sn = (f32x4){0.f, 0.f, 0.f, 0.f};
                    { const float* tp = ropeD + (size_t)(row & 4095) * 8; const f32x4 c4 = *(const f32x4*)tp, s4 = *(const f32x4*)(tp + 4); if (rotl) { cs = c4; sn = s4; } }
#pragma unroll
                    for (int bj = 0; bj < 2; ++bj) { const f32x4 x1 = acc[ai][bj][m][0] * rs, x2 = acc[ai][bj][m][1] * rs;
                        const f32x4 o1 = x1 * cs - x2 * sn, o2 = x2 * cs + x1 * sn;
                        if (pn == 6) { const int comp = 4 * bj + wc, which = comp & 1; bf16_t* q = qd + (size_t)row * 512 + comp * 64 + 8 * fq;
                            *(u32x4*)(q + which * 32) = pack8(o1 * SCALE_D, o2 * SCALE_D); *(u32x4*)(q + (1 - which) * 32) = (u32x4){0u, 0u, 0u, 0u}; }
                        else *(u32x4*)(ub + 5 * bstride + (size_t)row * 256 + bj * HALF + cl) = pack8(o1, o2); }
                    asm volatile("" ::: "memory"); }
        }
    }
};
template <bool DO_SS, bool F8, bool XF32> struct EpiRes {
    static constexpr bool PERM = true, AFTER_DRAIN = false;
    const float* xin; bf16_t* xb; unsigned char* xb8; float* ss; float ascale;
    __device__ __forceinline__ void operator()(const f32x4 (&acc)[2][2][4][2], const Unit& u, int wr, int wc, int fr, int fq) const {
        asm volatile("" : "+v"(fr), "+v"(fq));
        const int row0 = u.pm * BM + wr * 64 + fr, col0 = u.pn * BM + wc * 32 + 8 * fq;
#pragma unroll
        for (int ai = 0; ai < 2; ++ai) {
            f32x4 res[4][2][2];
#pragma unroll
            for (int m = 0; m < 4; ++m) { const size_t off = (size_t)(row0 + ai * HALF + m * 16) * 1024 + col0;
#pragma unroll
                for (int bj = 0; bj < 2; ++bj) { const size_t o = off + bj * HALF;
                    if (XF32) { res[m][bj][0] = __builtin_nontemporal_load((const f32x4*)(xin + o)); res[m][bj][1] = __builtin_nontemporal_load((const f32x4*)(xin + o + 4)); }
                    else { const u32x4 w = *(const u32x4*)(xb + o);
                        res[m][bj][0] = (f32x4){__uint_as_float(w.x << 16), __uint_as_float(w.x & 0xffff0000u), __uint_as_float(w.y << 16), __uint_as_float(w.y & 0xffff0000u)};
                        res[m][bj][1] = (f32x4){__uint_as_float(w.z << 16), __uint_as_float(w.z & 0xffff0000u), __uint_as_float(w.w << 16), __uint_as_float(w.w & 0xffff0000u)}; } } }
            u32x2 w8[2][2];
#pragma unroll
            for (int m = 0; m < 4; ++m) { const int row = row0 + ai * HALF + m * 16; const size_t off = (size_t)row * 1024 + col0; float part = 0.f;
#pragma unroll
                for (int bj = 0; bj < 2; ++bj) { const size_t o = off + bj * HALF;
                    const f32x4 v0 = res[m][bj][0] + acc[ai][bj][m][0] * ascale, v1 = res[m][bj][1] + acc[ai][bj][m][1] * ascale;
                    *(u32x4*)(xb + o) = pack8(v0, v1);
                    if (F8) { u32x2 w; w.x = pack4_fp8(v0[0] * F8_ACT, v0[1] * F8_ACT, v0[2] * F8_ACT, v0[3] * F8_ACT); w.y = pack4_fp8(v1[0] * F8_ACT, v1[1] * F8_ACT, v1[2] * F8_ACT, v1[3] * F8_ACT); w8[m & 1][bj] = w;
                        if (m & 1) st16_rowpair(w8[0][bj], w8[1][bj], xb8 + o - (size_t)(16 - 16 * (fq & 1)) * 1024 - 8 * (fq & 1)); }
                    const f32x4 q = v0 * v0 + v1 * v1; part += (q[0] + q[1]) + (q[2] + q[3]); }
                if (DO_SS) { part += __shfl_xor(part, 16); part += __shfl_xor(part, 32);
                    if (fq == 0) ss[(size_t)row * 16 + u.pn * 4 + wc] = part; } }
            asm volatile("" ::: "memory"); }
    }
};
template <bool PARTS, bool F8> struct EpiGlu {
    static constexpr bool PERM = true, AFTER_DRAIN = false;
    void* Hv; int ldh; const float* ss; int o_off;
    __device__ __forceinline__ void operator()(const f32x4 (&acc)[2][2][4][2], const Unit& u, int wr, int wc, int fr, int fq) const {
        asm volatile("" : "+v"(fr), "+v"(fq));
        const int row0 = u.pm * BM + wr * 64 + fr; const size_t c0 = (size_t)u.pn * HALF + wc * 32 + 8 * fq;
        float rs8[2][4];
        if (!PARTS) {
#pragma unroll
            for (int ai = 0; ai < 2; ++ai)
#pragma unroll
                for (int m = 0; m < 4; ++m) rs8[ai][m] = ss[row0 + ai * HALF + m * 16]; }
#pragma unroll
        for (int ai = 0; ai < 2; ++ai) {
            float rsv[4]; f32x4 rq[4]; u32x2 w8[4];
#pragma unroll
            for (int m = 0; m < 4; ++m) rq[m] = PARTS ? rsum_ld<PARTS>(ss, row0 + ai * HALF + m * 16, fq) : (f32x4){rs8[ai][m], 0.f, 0.f, 0.f};
#pragma unroll
            for (int m = 0; m < 4; ++m) rsv[m] = __builtin_amdgcn_rsqf((PARTS ? rsum_fin<PARTS>(rq[m]) : rq[m][0]) * (1.0f / 1024.0f) + RMS_EPS) * (F8 ? F8_INV : 1.0f);
#pragma unroll
            for (int m = 0; m < 4; ++m) { const int row = row0 + ai * HALF + m * 16; const float rs = rsv[m];
                f32x4 z0, z1;
                { const float rsn = rs * -1.4426950408889634f, rsu = rs * (F8 ? F8_ACT : 1.0f);
                  const f32x4 g0 = acc[ai][0][m][0] * rs, g1 = acc[ai][0][m][1] * rs, t0 = acc[ai][0][m][0] * rsn, t1 = acc[ai][0][m][1] * rsn, u0 = acc[ai][1][m][0] * rsu, u1 = acc[ai][1][m][1] * rsu;
                  f32x4 e0, e1;
#pragma unroll
                  for (int j = 0; j < 4; ++j) { e0[j] = __builtin_amdgcn_exp2f(t0[j]); e1[j] = __builtin_amdgcn_exp2f(t1[j]); }
                  e0 = e0 + 1.0f; e1 = e1 + 1.0f;
#pragma unroll
                  for (int j = 0; j < 4; ++j) { e0[j] = __builtin_amdgcn_rcpf(e0[j]); e1[j] = __builtin_amdgcn_rcpf(e1[j]); }
                  z0 = (g0 * e0) * u0; z1 = (g1 * e1) * u1; }
                const size_t o = (size_t)(row - o_off * BM) * ldh + c0;
                if (F8) { w8[m].x = pack4_fp8(z0[0], z0[1], z0[2], z0[3]); w8[m].y = pack4_fp8(z1[0], z1[1], z1[2], z1[3]);
                    if (m & 1) st16_rowpair(w8[(m - 1) & 3], w8[m], (unsigned char*)Hv + (size_t)(row - 16 + 16 * (fq & 1) - o_off * BM) * ldh + (c0 - 8 * (fq & 1))); }
                else *(u32x4*)((bf16_t*)Hv + o) = pack8(z0, z1);
                asm volatile("" ::: "memory"); } }
    }
};
struct EpiY {
    static constexpr bool PERM = true, AFTER_DRAIN = false;
    unsigned char* Y;
    __device__ __forceinline__ void operator()(const f32x4 (&acc)[2][2][4][2], const Unit& u, int wr, int wc, int fr, int fq) const {
        asm volatile("" : "+v"(fr), "+v"(fq));
        const int row0 = u.pm * BM + wr * 64 + fr; unsigned char* O = Y + (size_t)u.pn * BM + wc * 32 + 8 * fq; constexpr float s = F8_INV * Y_SCALE;
#pragma unroll
        for (int ai = 0; ai < 2; ++ai)
#pragma unroll
            for (int m = 0; m < 4; m += 2) { const int row = row0 + ai * HALF + m * 16 + 16 * (fq & 1);
#pragma unroll
                for (int bj = 0; bj < 2; ++bj) { u32x2 w[2];
#pragma unroll
                    for (int t = 0; t < 2; ++t) { const f32x4 v0 = acc[ai][bj][m + t][0] * s, v1 = acc[ai][bj][m + t][1] * s; w[t].x = pack4_fp8(v0[0], v0[1], v0[2], v0[3]); w[t].y = pack4_fp8(v1[0], v1[1], v1[2], v1[3]); }
                    st16_rowpair(w[0], w[1], O + (size_t)row * 1024 + bj * HALF - 8 * (fq & 1)); } }
    }
};
#ifndef F8_SCALE
#define F8_SCALE 0x7F7F7F7F
#endif
typedef int v4i32 __attribute__((ext_vector_type(4))); typedef int v8i32 __attribute__((ext_vector_type(8)));
__device__ __forceinline__ v8i32 cat8(const bf16x8 lo, const bf16x8 hi) { return __builtin_shufflevector(__builtin_bit_cast(v4i32, lo), __builtin_bit_cast(v4i32, hi), 0, 1, 2, 3, 4, 5, 6, 7); }
template <class Epi, class Sched, bool ALIGN_EPI = false, bool SP2 = false, bool F8 = false>
__device__ __forceinline__ void gemm_phase(PG8_LAS unsigned char* lds, const Gemm g, const Sched& S, const Epi& E) {
    int tid_ = threadIdx.x; asm volatile("" : "+v"(tid_));
    const int tid = tid_, wid = __builtin_amdgcn_readfirstlane(tid >> 6), lane = tid & 63, wr = wid >> 2, wc = wid & 3, fr = lane & 15, fq = lane >> 4;
    const int K = g.K, nt = K / BK;
    unsigned voffA[2], voffB[2];
#pragma unroll
    for (int i = 0; i < 2; ++i) { int R, C; stage_rc(tid * 16 + i * 8192, R, C); const int Rb = Epi::PERM ? ((R & ~31) + perm32(R & 31)) : R;
        voffA[i] = (unsigned)(R * K + C) * 2u; voffB[i] = (unsigned)(Rb * K + C) * 2u; }
    const size_t kstep = (size_t)(BK * 2);
    const size_t hstep = (size_t)HALF * K * 2;
    const unsigned ldsw = (unsigned)wid * 1024u;
    const int aoff = lds_byte(wr * 64 + fr, fq * 8), boff = lds_byte(wc * 32 + fr, fq * 8);
#define PG8_SA(b, h) (((b) * 2 + (h)) * HTB)
#define PG8_SB(b, h) ((4 + (b) * 2 + (h)) * HTB)
#define PG8_STAGE(bufoff, gbase, voff) do { _Pragma("unroll") for (int _i = 0; _i < 2; ++_i) \
        __builtin_amdgcn_global_load_lds((const unsigned*)((const char*)(gbase) + (voff)[_i]), (PG8_LAS unsigned*)(lds + (bufoff) + ldsw + _i * 8192), 16, 0, 0); } while (0)
#define PG8_LDA(dst, b, h) do { _Pragma("unroll") for (int m = 0; m < 4; ++m) _Pragma("unroll") for (int k = 0; k < 2; ++k) dst[m][k] = *(const PG8_LAS bf16x8*)(lds + PG8_SA(b, h) + aoff + m * 2048 + k * 1024); } while (0)
#define PG8_LDB(dst, b, h) do { _Pragma("unroll") for (int n = 0; n < 2; ++n) _Pragma("unroll") for (int k = 0; k < 2; ++k) dst[n][k] = *(const PG8_LAS bf16x8*)(lds + PG8_SB(b, h) + boff + n * 2048 + k * 1024); } while (0)
#define PG8_MMA(ai, bj, At, Bt) do { __builtin_amdgcn_s_setprio(1); _Pragma("unroll") for (int m = 0; m < 4; ++m) _Pragma("unroll") for (int n = 0; n < 2; ++n) { \
        if constexpr (F8) { const v8i32 b8_ = cat8(Bt[n][0], Bt[n][1]), a8_ = cat8(At[m][0], At[m][1]); \
            asm volatile("v_mfma_scale_f32_16x16x128_f8f6f4 %0, %1, %2, %0, %3, %3 op_sel_hi:[0,0,0]" : "+v"(acc[ai][bj][m][n]) : "v"(b8_), "v"(a8_), "v"(f8scale_)); }     \
        else { _Pragma("unroll") for (int k = 0; k < 2; ++k) acc[ai][bj][m][n] = __builtin_amdgcn_mfma_f32_16x16x32_bf16(Bt[n][k], At[m][k], acc[ai][bj][m][n], 0, 0, 0); } } __builtin_amdgcn_s_setprio(0); } while (0)
#define PG8_WAIT_V(n) asm volatile("s_waitcnt vmcnt(" #n ")" ::: "memory")
#define PG8_WAIT_L(n) asm volatile("s_waitcnt lgkmcnt(" #n ")" ::: "memory")
#define PG8_BAR __builtin_amdgcn_s_barrier()
#define PG8_SCHED __builtin_amdgcn_sched_barrier(0)
    int f8scale_ = F8_SCALE; asm volatile("" : "+v"(f8scale_));
    Unit cur, nxt; int ui = 0;
    if (!S.next(0, cur)) return;
    f32x4 acc[2][2][4][2];
#pragma unroll
    for (int a = 0; a < 2; ++a)
#pragma unroll
        for (int b = 0; b < 2; ++b)
#pragma unroll
            for (int m = 0; m < 4; ++m)
#pragma unroll
                for (int n = 0; n < 2; ++n) acc[a][b][m][n] = (f32x4){0.f, 0.f, 0.f, 0.f};
    bf16x8 At[4][2], B0[2][2], B1[2][2];
    const char* cA = S.a_ptr(g, cur); const char* cB = S.b_ptr(g, cur);
    S.a_ready(cur);
    if constexpr (SP2) {
        PG8_STAGE(PG8_SB(0, 0), cB, voffB); PG8_STAGE(PG8_SB(0, 1), cB + hstep, voffB); PG8_STAGE(PG8_SA(0, 0), cA, voffA); PG8_STAGE(PG8_SA(0, 1), cA + hstep, voffA);
        if (wr == 1) PG8_BAR;
        PG8_WAIT_V(2); PG8_BAR;
        PG8_STAGE(PG8_SB(1, 0), cB + kstep, voffB); PG8_STAGE(PG8_SA(1, 0), cA + kstep, voffA); PG8_STAGE(PG8_SB(1, 1), cB + hstep + kstep, voffB);
        PG8_WAIT_V(6); PG8_BAR;
    } else {
        PG8_STAGE(PG8_SB(0, 0), cB, voffB); PG8_STAGE(PG8_SA(0, 0), cA, voffA); PG8_STAGE(PG8_SB(0, 1), cB + hstep, voffB); PG8_STAGE(PG8_SA(0, 1), cA + hstep, voffA);
        if (wr == 1) PG8_BAR;
        PG8_WAIT_V(4); PG8_BAR;
        PG8_STAGE(PG8_SB(1, 0), cB + kstep, voffB); PG8_STAGE(PG8_SA(1, 0), cA + kstep, voffA); PG8_STAGE(PG8_SB(1, 1), cB + hstep + kstep, voffB);
        PG8_WAIT_V(6); PG8_BAR;
    }
    for (;;) {
        const bool has_next = S.next(ui + 1, nxt);
        const char* nA = has_next ? S.a_ptr(g, nxt) : cA; const char* nB = has_next ? S.b_ptr(g, nxt) : cB;
#pragma nounroll
        for (int t = 0; t < nt; t += 2) {
            const bool last = (t == nt - 2);
            const char* a1 = cA + (size_t)(t + 1) * kstep;
            const char* a2 = last ? nA : cA + (size_t)(t + 2) * kstep; const char* b2 = last ? nB : cB + (size_t)(t + 2) * kstep;
            const char* a3 = a2 + kstep; const char* b3 = b2 + kstep;
            if (last && has_next) S.a_ready(nxt);
            if constexpr (SP2) {
            PG8_LDB(B0, 0, 0); PG8_LDB(B1, 0, 1); PG8_SCHED; PG8_LDA(At, 0, 0); PG8_STAGE(PG8_SA(1, 1), a1 + hstep, voffA);
            PG8_WAIT_V(8); PG8_WAIT_L(0); PG8_BAR; PG8_MMA(0, 0, At, B0); PG8_MMA(0, 1, At, B1); PG8_BAR; PG8_SCHED;
            PG8_LDA(At, 0, 1); PG8_STAGE(PG8_SB(0, 0), b2, voffB); PG8_STAGE(PG8_SB(0, 1), b2 + hstep, voffB); PG8_STAGE(PG8_SA(0, 0), a2, voffA);
            PG8_WAIT_V(8); PG8_WAIT_L(0); PG8_BAR; PG8_MMA(1, 0, At, B0); PG8_MMA(1, 1, At, B1); PG8_BAR; PG8_SCHED;
            PG8_LDB(B0, 1, 0); PG8_LDB(B1, 1, 1); PG8_SCHED; PG8_LDA(At, 1, 0); PG8_STAGE(PG8_SA(0, 1), a2 + hstep, voffA);
            PG8_WAIT_V(8); PG8_WAIT_L(0); PG8_BAR; PG8_MMA(0, 0, At, B0); PG8_MMA(0, 1, At, B1); PG8_BAR; PG8_SCHED;
            PG8_LDA(At, 1, 1); PG8_STAGE(PG8_SB(1, 0), b3, voffB); PG8_STAGE(PG8_SB(1, 1), b3 + hstep, voffB); PG8_STAGE(PG8_SA(1, 0), a3, voffA);
            PG8_WAIT_V(8); PG8_WAIT_L(0); PG8_BAR; PG8_MMA(1, 0, At, B0); PG8_MMA(1, 1, At, B1); PG8_BAR; PG8_SCHED;
            } else {
            PG8_LDB(B0, 0, 0); PG8_SCHED; PG8_LDA(At, 0, 0); PG8_STAGE(PG8_SA(1, 1), a1 + hstep, voffA);
            PG8_WAIT_L(8); PG8_BAR; PG8_WAIT_L(0); PG8_MMA(0, 0, At, B0); PG8_BAR; PG8_SCHED;
            PG8_LDB(B1, 0, 1); PG8_STAGE(PG8_SB(0, 0), b2, voffB);
            PG8_BAR; PG8_WAIT_L(0); PG8_MMA(0, 1, At, B1); PG8_BAR;
            PG8_LDA(At, 0, 1); PG8_STAGE(PG8_SA(0, 0), a2, voffA);
            PG8_BAR; PG8_WAIT_L(0); PG8_MMA(1, 0, At, B0); PG8_BAR; PG8_SCHED;
            PG8_STAGE(PG8_SB(0, 1), b2 + hstep, voffB);
            PG8_WAIT_V(6); PG8_BAR; PG8_MMA(1, 1, At, B1); PG8_BAR;
            PG8_LDB(B0, 1, 0); PG8_SCHED; PG8_LDA(At, 1, 0); PG8_STAGE(PG8_SA(0, 1), a2 + hstep, voffA);
            PG8_WAIT_L(8); PG8_BAR; PG8_WAIT_L(0); PG8_MMA(0, 0, At, B0); PG8_BAR; PG8_SCHED;
            PG8_LDB(B1, 1, 1); PG8_STAGE(PG8_SB(1, 0), b3, voffB);
            PG8_BAR; PG8_WAIT_L(0); PG8_MMA(0, 1, At, B1); PG8_BAR;
            PG8_LDA(At, 1, 1); PG8_STAGE(PG8_SA(1, 0), a3, voffA);
            PG8_BAR; PG8_WAIT_L(0); PG8_MMA(1, 0, At, B0); PG8_BAR; PG8_SCHED;
            PG8_STAGE(PG8_SB(1, 1), b3 + hstep, voffB);
            PG8_WAIT_V(6); PG8_BAR; PG8_MMA(1, 1, At, B1); PG8_BAR;
            }
        }
        if constexpr (ALIGN_EPI) { if (wr == 0) PG8_BAR; }
        if constexpr (F8) {
#define PG8_PIN8(a, b) asm volatile("" : "+v"(acc[a][b][0][0]), "+v"(acc[a][b][0][1]), "+v"(acc[a][b][1][0]), "+v"(acc[a][b][1][1]), "+v"(acc[a][b][2][0]), "+v"(acc[a][b][2][1]), "+v"(acc[a][b][3][0]), "+v"(acc[a][b][3][1]))
            asm volatile("s_nop 15\n\ts_nop 15" ::: "memory"); PG8_PIN8(0, 0); PG8_PIN8(0, 1); PG8_PIN8(1, 0); PG8_PIN8(1, 1);
#undef PG8_PIN8
        }
        if constexpr (!Epi::AFTER_DRAIN) { E(acc, cur, wr, wc, fr, fq);
#if defined(PG8_EPI_TWICE)
            if constexpr (Epi::PERM) { asm volatile("" ::: "memory"); E(acc, cur, wr, wc, fr, fq); }
#endif
            S.done(cur); }
        if (!has_next) break;
#pragma unroll
        for (int a = 0; a < 2; ++a)
#pragma unroll
            for (int b = 0; b < 2; ++b)
#pragma unroll
                for (int m = 0; m < 4; ++m)
#pragma unroll
                    for (int n = 0; n < 2; ++n) acc[a][b][m][n] = (f32x4){0.f, 0.f, 0.f, 0.f};
        cur = nxt; cA = nA; cB = nB; ++ui;
        if constexpr (ALIGN_EPI) { if (wr == 1) PG8_BAR; }
    }
    PG8_WAIT_V(0);
    if constexpr (!ALIGN_EPI) { if (wr == 0) PG8_BAR; }
    PG8_BAR;
    if constexpr (Epi::AFTER_DRAIN) { E.fused(acc, cur, wr, wc, fr, fq, lds, wid, lane); S.done(cur); }
#undef PG8_SA
#undef PG8_SB
#undef PG8_STAGE
#undef PG8_LDA
#undef PG8_LDB
#undef PG8_MMA
#undef PG8_WAIT_V
#undef PG8_WAIT_L
#undef PG8_BAR
#undef PG8_SCHED
}
}
namespace attn_body {
using bf16=__hip_bfloat16;
using bf16x8=__attribute__((ext_vector_type(8)))short;
using s16x4=__attribute__((ext_vector_type(4)))short;
using f32x16=__attribute__((ext_vector_type(16)))float;
using u32x4=__attribute__((ext_vector_type(4)))unsigned;
constexpr int SEQ=4096,D=64,QP=512,KP=256;
constexpr int NW=8,QBLK=32,QB=QBLK*NW,KVBLK=64,NQB=SEQ/QB;
constexpr int ATTN_UNIT_ROWS=QB;
__device__ __forceinline__ int crow(int r,int hi){return (r&3)+8*(r>>2)+4*hi;}
#define SBAR() __builtin_amdgcn_sched_barrier(0)
__device__ __forceinline__ void cmask(f32x16&p0,f32x16&p1,int jb,int qrel,int hi){
  const float NEG=-INFINITY; int kb=64*jb+4*hi;
  #pragma unroll
  for(int r=0;r<16;++r){int kv=kb+(r&3)+8*(r>>2); if(kv>qrel)p0[r]=NEG; if(kv+32>qrel)p1[r]=NEG;}
}

constexpr int NSLOT=3, SLOTB=8192;
constexpr int LDS_K=0, LDS_V=NSLOT*SLOTB, LDS_WS=2*NSLOT*SLOTB, LDS_OST=LDS_WS+NW*64*4, LDS_OA=LDS_OST+NW*4096, LDS_BYTES=LDS_OA+NW*4096;
constexpr float C2=0.125f*1.4426950408889634f;
__device__ __forceinline__ void glds16(const void*gsrc,unsigned lds_dst){unsigned keep;
  asm volatile("s_mov_b32 %0, m0\n\ts_mov_b32 m0, %2\n\ts_nop 0\n\tglobal_load_lds_dwordx4 %1, off\n\ts_mov_b32 m0, %0":"=&s"(keep):"v"(gsrc),"s"(lds_dst):"memory");}
__device__ __forceinline__ float max3f(float a,float b,float c){float r;asm("v_max3_f32 %0, %1, %2, %3":"=v"(r):"v"(a),"v"(b),"v"(c));return r;}
__device__ __forceinline__ float max2f(float a,float b){float r;asm("v_max_f32_e32 %0, %1, %2":"=v"(r):"v"(a),"v"(b));return r;}
__device__ __forceinline__ float fadd_s(float a,float b){float r;asm("v_add_f32_e32 %0, %1, %2":"=v"(r):"v"(a),"v"(b));return r;}
__device__ __forceinline__ float fsub_s(float a,float b){float r;asm("v_sub_f32_e32 %0, %1, %2":"=v"(r):"v"(a),"v"(b));return r;}
typedef float f32x2_t __attribute__((ext_vector_type(2))); typedef __bf16 bf16x2_t __attribute__((ext_vector_type(2)));
__device__ __forceinline__ unsigned cvtpk_s(float lo,float hi){f32x2_t v={lo,hi};bf16x2_t b=__builtin_convertvector(v,bf16x2_t);return __builtin_bit_cast(unsigned,b);}
#define WAIT_BAR(N) asm volatile("s_waitcnt vmcnt(" #N ") lgkmcnt(0)\n\ts_barrier":::"memory")

template<int D0A,int D0B> __device__ __forceinline__ void qkt(f32x16&p0,f32x16&p1,const char*Kslot,const bf16x8*qr,const f32x16&negm,int r32,int hi){
  const char*kb=Kslot+hi*1024+r32*16;
  #pragma unroll
  for(int d0=D0A;d0<D0B;++d0){
    const bf16x8 b0=*reinterpret_cast<const bf16x8*>(kb+d0*2048);
    const bf16x8 b1=*reinterpret_cast<const bf16x8*>(kb+d0*2048+512);
    if(d0==D0A){p0=__builtin_amdgcn_mfma_f32_32x32x16_bf16(b0,qr[d0],negm,0,0,0);p1=__builtin_amdgcn_mfma_f32_32x32x16_bf16(b1,qr[d0],negm,0,0,0);}
    else{p0=__builtin_amdgcn_mfma_f32_32x32x16_bf16(b0,qr[d0],p0,0,0,0);p1=__builtin_amdgcn_mfma_f32_32x32x16_bf16(b1,qr[d0],p1,0,0,0);}}
}
typedef __attribute__((address_space(3))) const char* lds_cptr;
typedef short v4i16_t __attribute__((ext_vector_type(4)));
__device__ __forceinline__ void kload8(bf16x8*kf,lds_cptr kp){
  kf[0]=*(const __attribute__((address_space(3))) bf16x8*)(kp);      kf[1]=*(const __attribute__((address_space(3))) bf16x8*)(kp+512);
  kf[2]=*(const __attribute__((address_space(3))) bf16x8*)(kp+2048); kf[3]=*(const __attribute__((address_space(3))) bf16x8*)(kp+2560);
  kf[4]=*(const __attribute__((address_space(3))) bf16x8*)(kp+4096); kf[5]=*(const __attribute__((address_space(3))) bf16x8*)(kp+4608);
  kf[6]=*(const __attribute__((address_space(3))) bf16x8*)(kp+6144); kf[7]=*(const __attribute__((address_space(3))) bf16x8*)(kp+6656);
}
__device__ __forceinline__ void kload2(bf16x8*kf,lds_cptr kp,int j){ kf[2*j]=*(const __attribute__((address_space(3))) bf16x8*)(kp+j*2048); kf[2*j+1]=*(const __attribute__((address_space(3))) bf16x8*)(kp+j*2048+512); }
__device__ __forceinline__ s16x4 vtr(lds_cptr p){ return __builtin_bit_cast(s16x4,__builtin_amdgcn_ds_read_tr16_b64_v4i16((__attribute__((address_space(3))) v4i16_t*)p)); }
__device__ __forceinline__ float rowmax(const f32x16&p0,const f32x16&p1){
  float a=max3f(p0[0],p0[1],p1[0]),b=max3f(p0[2],p0[3],p1[1]);a=max3f(a,p1[2],p1[3]);
  #pragma unroll
  for(int r=4;r<16;r+=4){a=max3f(a,p0[r],p0[r+1]);b=max3f(b,p0[r+2],p0[r+3]);a=max3f(a,p1[r],p1[r+1]);b=max3f(b,p1[r+2],p1[r+3]);}
  const float m=max2f(a,b);
  auto rr=__builtin_amdgcn_permlane32_swap(__float_as_uint(m),__float_as_uint(m),false,false);
  return max2f(__uint_as_float(rr[0]),__uint_as_float(rr[1]));
}
__device__ __forceinline__ void pv(f32x16*o,int vb,bf16x8 pa0,bf16x8 pa1,bf16x8 pa2,bf16x8 pa3){
  #pragma unroll
  for(int d0=0;d0<2;++d0){s16x4 lo[4],hi[4];
    #pragma unroll
    for(int ks=0;ks<4;++ks){
      asm volatile("ds_read_b64_tr_b16 %0,%1 offset:%c2":"=&v"(lo[ks]):"v"(vb),"i"(d0*4096+ks*1024):"memory");
      asm volatile("ds_read_b64_tr_b16 %0,%1 offset:%c2":"=&v"(hi[ks]):"v"(vb),"i"(d0*4096+ks*1024+512):"memory");}
    asm volatile("s_waitcnt lgkmcnt(0)":::"memory");SBAR();
    #define PK(k) (bf16x8){lo[k][0],lo[k][1],lo[k][2],lo[k][3],hi[k][0],hi[k][1],hi[k][2],hi[k][3]}
    o[d0]=__builtin_amdgcn_mfma_f32_32x32x16_bf16(pa0,PK(0),o[d0],0,0,0);
    o[d0]=__builtin_amdgcn_mfma_f32_32x32x16_bf16(pa1,PK(1),o[d0],0,0,0);
    o[d0]=__builtin_amdgcn_mfma_f32_32x32x16_bf16(pa2,PK(2),o[d0],0,0,0);
    o[d0]=__builtin_amdgcn_mfma_f32_32x32x16_bf16(pa3,PK(3),o[d0],0,0,0);
    #undef PK
  }
}

#ifndef ATTN_STORE16
#define ATTN_STORE16(p,v) (*(u32x4*)(p)=(v))
#endif
template<int THRL,int MODE> __device__ __forceinline__ void attn_unit(int b,int h,int qb,const bf16*Q,const bf16*__restrict__ K,const bf16*__restrict__ V,bf16*O,char*shm,float lam=0.f,float omli=0.f,const float*dg=nullptr){
  constexpr int D0A=(MODE==2)?2:0, D0B=(MODE==1)?2:4;
  int tid_=threadIdx.x; asm volatile("":"+v"(tid_));
  const int tid=tid_,lane=tid&63,r32=lane&31,hi=lane>>5; const int wid=__builtin_amdgcn_readfirstlane(tid>>6);
  const long rowbase=(long)b*SEQ; const int q0=qb*QB;
  const bf16*Qw=Q+(rowbase+q0+wid*QBLK)*QP+h*D;
  const bf16*Kh=K+rowbase*KP+(h>>1)*D,*Vh=V+rowbase*KP+(h>>1)*D;
  const unsigned lds0=(unsigned)(uintptr_t)shm;
  float*wsf=(float*)(shm+LDS_WS)+wid*64;
  const bf16*ksrc=Kh+(long)lane*KP+wid*8;
  const bf16*vsrc=Vh+(long)(16*(wid&3)+(lane>>2))*KP+(wid>>2)*32+(lane&3)*8;
  const unsigned kdst=lds0+LDS_K+wid*1024, vdst=lds0+LDS_V+wid*1024;
  #define DMA_K(t,slot) glds16(ksrc+(long)(t)*KVBLK*KP,(unsigned)__builtin_amdgcn_readfirstlane(kdst+(slot)))
  #define DMA_V(t,slot) glds16(vsrc+(long)(t)*KVBLK*KP,(unsigned)__builtin_amdgcn_readfirstlane(vdst+(slot)))
  const int vb0=(int)(lds0+LDS_V)+((lane>>4)&1)*32+(lane&3)*8+(4*hi+((lane&15)>>2))*64;
  const char*Kbase=shm+LDS_K; bf16x8 kf[8];
  const lds_cptr shm3=(lds_cptr)shm; const lds_cptr kp0=shm3+LDS_K+hi*1024+r32*16; const lds_cptr vp0=shm3+LDS_V+((lane>>4)&1)*32+(lane&3)*8+(4*hi+((lane&15)>>2))*64;
  const int NT=(q0+QB)/KVBLK;
  DMA_K(0,0);DMA_V(0,0);DMA_K(1,SLOTB);
  bf16x8 qr[4];
  #pragma unroll
  for(int d0=D0A;d0<D0B;++d0)qr[d0]=*reinterpret_cast<const bf16x8*>(&Qw[(long)r32*QP+d0*16+hi*8]);
  float mhat=0.f,l_reg=0.f;f32x16 o[2];o[0]=f32x16{};o[1]=f32x16{};f32x16 negm=f32x16{};asm volatile("":"+v"(negm));
  const int qrel=wid*QBLK+r32;
  #define CMASK(P0,P1,t) do{int jb_=(t)-(NT-4); if(jb_>=0)cmask(P0,P1,jb_,qrel,hi);}while(0)
  bool resc=false;
  #define START(P0,P1) do{ const float rm=rowmax(P0,P1); resc=false; \
    { const float dl=rm; mhat=fadd_s(mhat,dl); \
      _Pragma("unroll") for(int r=0;r<16;++r){P0[r]=fsub_s(P0[r],dl);P1[r]=fsub_s(P1[r],dl);} \
      _Pragma("unroll") for(int r=0;r<16;++r)negm[r]=-mhat; asm volatile("":"+v"(negm)); } \
    _Pragma("unroll") for(int r=0;r<16;++r)P0[r]=__builtin_amdgcn_exp2f(P0[r]); }while(0)
  #define RESC() do{ if(resc){ asm volatile("s_waitcnt lgkmcnt(0)":::"memory"); \
      _Pragma("unroll") for(int d_=0;d_<2;++d_) _Pragma("unroll") for(int r=0;r<16;++r)o[d_][r]*=wsf[crow(r,hi)]; } }while(0)
  f32x16 pA0,pA1,pB0,pB1;
  int sl_prev=0,sl_cur=0,sl_next=SLOTB;
  #define ROT() do{sl_prev=sl_cur;sl_cur=sl_next;sl_next=(sl_next==(NSLOT-1)*SLOTB)?0:sl_next+SLOTB;}while(0)
  DMA_K(2,2*SLOTB);
  WAIT_BAR(3);
  qkt<D0A,D0B>(pA0,pA1,Kbase,qr,negm,r32,hi);asm volatile("s_nop 15\n\ts_nop 7":"+v"(pA0),"+v"(pA1));CMASK(pA0,pA1,0);
  START(pA0,pA1);
  _Pragma("unroll") for(int r=0;r<16;++r)pA1[r]=__builtin_amdgcn_exp2f(pA1[r]);
  WAIT_BAR(0);
  DMA_K(3,0);DMA_V(1,SLOTB);
  ROT();
  _Pragma("unroll") for(int j_=D0A;j_<D0B;++j_)kload2(kf,kp0+sl_cur,j_);
  WAIT_BAR(2);
  s16x4 vlo[8],vhi[8]; u32x4 pw0,pw1,pw2,pw3;
  #define PKW(P,B) cvtpk_s(P[B],P[B+1])
  #define PAF(k) __builtin_bit_cast(bf16x8,pw##k)
  #define VFR(i) (bf16x8){vlo[i][0],vlo[i][1],vlo[i][2],vlo[i][3],vhi[i][0],vhi[i][1],vhi[i][2],vhi[i][3]}
  #define PIN(x) asm volatile("":"+v"(x))
  #define MX3(a,b,c) __builtin_fmaxf(__builtin_fmaxf((a),(b)),(c))
  #define QKM(s,C) do{ if constexpr(((s)>>1)>=D0A&&((s)>>1)<D0B){ if constexpr(((s)>>1)==D0A) C=__builtin_amdgcn_mfma_f32_32x32x16_bf16(kf[s],qr[(s)>>1],negm,0,0,0); else C=__builtin_amdgcn_mfma_f32_32x32x16_bf16(kf[s],qr[(s)>>1],C,0,0,0); } }while(0)
  #define GAPA(MF,A0,A1,A2,A3,W0,W1,PW) do{ MF; sacc+=A0; sacc+=A1; sacc+=A2; sacc+=A3; PIN(sacc); W0; W1; PIN(PW); SBAR(); }while(0)
  #define EX(v) __builtin_amdgcn_exp2f(v)
  #define GAPB(MF,X,B) do{ MF; X[B]=EX(X[B]); X[B+1]=EX(X[B+1]); X[B+2]=EX(X[B+2]); X[B+3]=EX(X[B+3]); PIN(X); SBAR(); }while(0)
  #define VRD(i) do{ vlo[i]=vtr(vp_+(((i)>>2)*4096+((i)&3)*1024)); vhi[i]=vtr(vp_+(((i)>>2)*4096+((i)&3)*1024+512)); }while(0)
  #define KRD(G,j) do{ if constexpr((j)>=D0A&&(j)<D0B){ if(G){ kload2(kf,kp0+sl_next,j); SBAR(); } } }while(0)
  #define STEP(C0,C1,P0,P1,t,GK,GV,GL) do{ SBAR(); \
    const lds_cptr vp_=vp0+sl_prev; \
    VRD(0); SBAR(); float sacc=(P0[0]+P0[1]); \
    GAPA(QKM(0,C0), P0[2],P0[3],P0[4],P0[5],     pw0[0]=PKW(P0,0), pw0[1]=PKW(P0,2), pw0); \
    VRD(4); SBAR(); GAPA(QKM(1,C1), P0[6],P0[7],P0[8],P0[9],     pw0[2]=PKW(P0,4), pw0[3]=PKW(P0,6), pw0); \
    VRD(1); SBAR(); GAPA(QKM(2,C0),   P0[10],P0[11],P0[12],P0[13], pw1[0]=PKW(P0,8), pw1[1]=PKW(P0,10), pw1); \
    VRD(5); SBAR(); GAPA(QKM(3,C1),   P0[14],P0[15],P1[0],P1[1],   pw1[2]=PKW(P0,12),pw1[3]=PKW(P0,14), pw1); \
    VRD(2); SBAR(); GAPA(QKM(4,C0),   P1[2],P1[3],P1[4],P1[5],     pw2[0]=PKW(P1,0), pw2[1]=PKW(P1,2), pw2); \
    VRD(6); SBAR(); GAPA(QKM(5,C1),   P1[6],P1[7],P1[8],P1[9],     pw2[2]=PKW(P1,4), pw2[3]=PKW(P1,6), pw2); \
    VRD(3); SBAR(); GAPA(QKM(6,C0),   P1[10],P1[11],P1[12],P1[13], pw3[0]=PKW(P1,8), pw3[1]=PKW(P1,10), pw3); \
    VRD(7); SBAR(); GAPA(QKM(7,C1),   P1[14],P1[15],0.f,0.f,       pw3[2]=PKW(P1,12),pw3[3]=PKW(P1,14), pw3); \
    l_reg+=sacc; \
    if(GK){DMA_K((t)+3,sl_cur);} if(GV){DMA_V((t)+1,sl_next);} \
    CMASK(C0,C1,t); \
    { float a=MX3(C0[0],C0[1],C1[0]),b=MX3(C0[2],C0[3],C1[1]); a=MX3(a,C1[2],C1[3]); \
      _Pragma("unroll") for(int r=4;r<16;r+=4){a=MX3(a,C0[r],C0[r+1]);b=MX3(b,C0[r+2],C0[r+3]);a=MX3(a,C1[r],C1[r+1]);b=MX3(b,C1[r+2],C1[r+3]);} \
      float rm=__builtin_fmaxf(a,b); { auto rr=__builtin_amdgcn_permlane32_swap(__float_as_uint(rm),__float_as_uint(rm),false,false); rm=__builtin_fmaxf(__uint_as_float(rr[0]),__uint_as_float(rr[1])); } \
      resc=false; \
      if(__builtin_expect(__any(rm>(float)THRL),0)){ const float dl=__builtin_fmaxf(rm,0.f); mhat+=dl; \
        _Pragma("unroll") for(int r=0;r<16;++r){C0[r]-=dl;C1[r]-=dl;} \
        _Pragma("unroll") for(int r=0;r<16;++r)negm[r]=-mhat; asm volatile("":"+v"(negm)); \
        const float f=__builtin_amdgcn_exp2f(-dl); l_reg*=f; if(hi==0)wsf[r32]=f; resc=true; } } \
    SBAR(); \
    GAPB(o[0]=__builtin_amdgcn_mfma_f32_32x32x16_bf16(PAF(0),VFR(0),o[0],0,0,0), C0,0); \
    GAPB(o[1]=__builtin_amdgcn_mfma_f32_32x32x16_bf16(PAF(0),VFR(4),o[1],0,0,0), C0,4); \
    KRD(GL,0); GAPB(o[0]=__builtin_amdgcn_mfma_f32_32x32x16_bf16(PAF(1),VFR(1),o[0],0,0,0), C0,8); \
    KRD(GL,1); GAPB(o[1]=__builtin_amdgcn_mfma_f32_32x32x16_bf16(PAF(1),VFR(5),o[1],0,0,0), C0,12); \
    KRD(GL,2); GAPB(o[0]=__builtin_amdgcn_mfma_f32_32x32x16_bf16(PAF(2),VFR(2),o[0],0,0,0), C1,0); \
    KRD(GL,3); GAPB(o[1]=__builtin_amdgcn_mfma_f32_32x32x16_bf16(PAF(2),VFR(6),o[1],0,0,0), C1,4); \
    GAPB(o[0]=__builtin_amdgcn_mfma_f32_32x32x16_bf16(PAF(3),VFR(3),o[0],0,0,0), C1,8); \
    GAPB(o[1]=__builtin_amdgcn_mfma_f32_32x32x16_bf16(PAF(3),VFR(7),o[1],0,0,0), C1,12); \
    }while(0)
  int t=1;
  #undef CMASK
  #define CMASK(P0,P1,t) do{}while(0)
  for(;t+5<NT;t+=2){
    STEP(pB0,pB1,pA0,pA1,t,true,true,true);     WAIT_BAR(2); RESC(); ROT();
    STEP(pA0,pA1,pB0,pB1,t+1,true,true,true);   WAIT_BAR(2); RESC(); ROT();
  }
  #undef CMASK
  #define CMASK(P0,P1,t) do{int jb_=(t)-(NT-4); if(jb_>=0)cmask(P0,P1,jb_,qrel,hi);}while(0)
  #define ENDW(tt) do{ if((tt)+3<NT){WAIT_BAR(2);} else if((tt)+2<NT){WAIT_BAR(1);} else {WAIT_BAR(0);} }while(0)
  for(;t+1<NT;t+=2){
    STEP(pB0,pB1,pA0,pA1,t,(t+3<NT),(t+1<NT),(t+1<NT));       ENDW(t);   RESC(); ROT();
    STEP(pA0,pA1,pB0,pB1,t+1,(t+4<NT),(t+2<NT),(t+2<NT));     ENDW(t+1); RESC(); ROT();
  }
  STEP(pB0,pB1,pA0,pA1,NT-1,false,false,false); RESC();
  { float sacc=pB0[0]+pB0[1]; _Pragma("unroll") for(int r=2;r<16;++r)sacc+=pB0[r]; _Pragma("unroll") for(int r=0;r<16;++r)sacc+=pB1[r]; l_reg+=sacc;
    pw0=(u32x4){PKW(pB0,0),PKW(pB0,2),PKW(pB0,4),PKW(pB0,6)};pw1=(u32x4){PKW(pB0,8),PKW(pB0,10),PKW(pB0,12),PKW(pB0,14)};pw2=(u32x4){PKW(pB1,0),PKW(pB1,2),PKW(pB1,4),PKW(pB1,6)};pw3=(u32x4){PKW(pB1,8),PKW(pB1,10),PKW(pB1,12),PKW(pB1,14)};
    SBAR(); pv(o,vb0+sl_cur,PAF(0),PAF(1),PAF(2),PAF(3)); }
  #undef PKW
  #undef PAF
  #undef VFR
  #undef PIN
  #undef MX3
  #undef GAPA
  #undef QKM
  #undef GAPB
  #undef EX
  #undef VRD
  #undef KRD
  #undef STEP
  #undef ENDW
  {auto rr=__builtin_amdgcn_permlane32_swap(__float_as_uint(l_reg),__float_as_uint(l_reg),false,false);l_reg=__uint_as_float(rr[0])+__uint_as_float(rr[1]);}
  if(hi==0)wsf[32+r32]=l_reg;asm volatile("s_waitcnt lgkmcnt(0)":::"memory");
  float rli[16];
  #pragma unroll
  for(int r=0;r<16;++r)rli[r]=__builtin_amdgcn_rcpf(wsf[32+crow(r,hi)]);
  { bf16*stg=(bf16*)(shm+(MODE==1?LDS_OA:LDS_OST))+wid*2048;
    #pragma unroll
    for(int r=0;r<16;++r){const int orow=crow(r,hi);
      #pragma unroll
      for(int d0=0;d0<2;++d0)stg[orow*64+d0*32+r32]=__float2bfloat16(o[d0][r]*rli[r]);}
    asm volatile("s_waitcnt lgkmcnt(0)":::"memory");
    if constexpr(MODE==0){ bf16*Ow=O+(rowbase+q0+wid*QBLK)*QP+h*D;
      #pragma unroll
      for(int i=0;i<4;++i){const int row=i*8+(lane>>3),ch=lane&7; const u32x4 v=*(const u32x4*)(stg+row*64+ch*8); ATTN_STORE16(Ow+(long)row*QP+ch*8,v);} }
    if constexpr(MODE==2){ const bf16*stgA=(const bf16*)(shm+LDS_OA)+wid*2048; bf16*Yw=O+(rowbase+q0+wid*QBLK)*1024+(h>>1)*D;
      const int ch=lane&7; float gg[8];
      #pragma unroll
      for(int j=0;j<8;++j)gg[j]=dg[ch*8+j];
      #pragma unroll
      for(int i=0;i<4;++i){const int row=i*8+(lane>>3); const u32x4 v2=*(const u32x4*)(stg+row*64+ch*8), v1=*(const u32x4*)(stgA+row*64+ch*8);
        float ov[8]; float ss=0.f;
        #pragma unroll
        for(int j=0;j<4;++j){ const float a0=__uint_as_float(v1[j]<<16),a1=__uint_as_float(v1[j]&0xffff0000u),c0=__uint_as_float(v2[j]<<16),c1=__uint_as_float(v2[j]&0xffff0000u);
          ov[2*j]=a0-lam*c0; ov[2*j+1]=a1-lam*c1; ss+=ov[2*j]*ov[2*j]+ov[2*j+1]*ov[2*j+1]; }
        ss+=__shfl_xor(ss,1); ss+=__shfl_xor(ss,2); ss+=__shfl_xor(ss,4);
        const float rs=omli/sqrtf(ss*(1.0f/64.0f)+1e-5f); u32x4 w;
        #pragma unroll
        for(int j=0;j<4;++j)w[j]=cvtpk_s(ov[2*j]*rs*gg[2*j],ov[2*j+1]*rs*gg[2*j+1]);
        ATTN_STORE16(Yw+(long)row*1024+ch*8,w);} } }
  asm volatile("s_waitcnt lgkmcnt(0)\n\ts_barrier":::"memory");
  #undef DMA_K
  #undef DMA_V
  #undef CMASK
  #undef START
  #undef RESC
  #undef ROT
}
constexpr int ATTN_LDS_BYTES=LDS_BYTES;
#undef SBAR
#undef WAIT_BAR
}
#define GAS __attribute__((address_space(1)))
#define LAS __attribute__((address_space(3)))
typedef unsigned short bf16;
typedef unsigned v4u __attribute__((ext_vector_type(4)));
typedef float f32x4 __attribute__((ext_vector_type(4)));
typedef short bf16x8 __attribute__((ext_vector_type(8)));
typedef GAS unsigned gu32;
typedef GAS unsigned long long gu64;
#define RLX_AGENT __ATOMIC_RELAXED, __HIP_MEMORY_SCOPE_AGENT
#define LDS_WAIT() asm volatile("s_waitcnt lgkmcnt(0)" ::: "memory")
#define VM_WAIT() asm volatile("s_waitcnt vmcnt(0)" ::: "memory")
__device__ __forceinline__ unsigned long long rt() { return __builtin_amdgcn_s_memrealtime(); }
__device__ __forceinline__ unsigned f2bf(float f) { unsigned u = __builtin_bit_cast(unsigned, f); return (u + 0x7fffu + ((u >> 16) & 1u)) >> 16; }
__device__ __forceinline__ unsigned pk2(float lo, float hi) { return f2bf(lo) | (f2bf(hi) << 16); }

#define XB_TMO      128
#define XB_XCNT(j)  (256  + 64 * (j))
#define XB_XSUB(j)  (1280 + 64 * (j))
#define XB_XGEN(j)  (2304 + 64 * (j))
#define XB_TOP      3328
#define XB_TOPGEN   3392
#define XCD_BAR_WORDS 3456
#define XB_SPIN_CAP (1u << 18)

__device__ __forceinline__ unsigned xb_ld(unsigned* p)              { return __hip_atomic_load(p, __ATOMIC_RELAXED, __HIP_MEMORY_SCOPE_AGENT); }
__device__ __forceinline__ unsigned xb_add(unsigned* p, unsigned v) { return __hip_atomic_fetch_add(p, v, __ATOMIC_RELAXED, __HIP_MEMORY_SCOPE_AGENT); }
__device__ __forceinline__ unsigned xb_xcc_id() { return (unsigned)__builtin_amdgcn_s_getreg((3 << 11) | 20) & 0xFu; }
#define XB_SPIN(cond, bar) do { unsigned _sp = 0; while (cond) { __builtin_amdgcn_s_sleep(1); \
    if ((++_sp & 255u) == 0u) { if (xb_ld(&(bar)[XB_TMO])) break; if (_sp > XB_SPIN_CAP) { atomicAdd(&(bar)[XB_TMO], 1u); break; } } } } while (0)

struct XcdBarrier {
    unsigned* bar; unsigned x;
    volatile LAS unsigned* st;
};

__device__ __forceinline__ XcdBarrier xcd_barrier_post(unsigned* bar, volatile LAS unsigned* st) {
    XcdBarrier b; b.bar = bar; b.x = xb_xcc_id(); b.st = st;
    if (threadIdx.x == 0) (void)xb_add(&bar[XB_XCNT(b.x)], 1u);
    return b;
}
__device__ __forceinline__ void xcd_barrier_complete(unsigned* bar, unsigned x, unsigned& nloc, unsigned& nx) {
    const unsigned G = gridDim.x * gridDim.y * gridDim.z;
    unsigned sum, cnt, mine, sp = 0u;
    for (;;) {
        sum = 0u; cnt = 0u; mine = 0u;
#pragma unroll
        for (unsigned j = 0; j < 16; ++j) { const unsigned c = xb_ld(&bar[XB_XCNT(j)]); sum += c; cnt += (c > 0u) ? 1u : 0u; mine = (j == x) ? c : mine; }
        if (sum == G) break;
        __builtin_amdgcn_s_sleep(1);
        if ((++sp & 255u) == 0u) { if (xb_ld(&bar[XB_TMO])) break; if (sp > XB_SPIN_CAP) { atomicAdd(&bar[XB_TMO], 1u); break; } }
    }
    nloc = mine > 0u ? mine : 1u; nx = cnt > 0u ? cnt : 1u;
}

__device__ __forceinline__ void xcd_barrier(const XcdBarrier& b) {
    asm volatile("s_waitcnt vmcnt(0)" ::: "memory");
    __syncthreads();
    if (threadIdx.x == 0) {
        unsigned* bar = b.bar;
        __builtin_amdgcn_s_waitcnt(0);
        unsigned nloc = b.st[0], nx = b.st[1];
        if (nloc == 0u) { xcd_barrier_complete(bar, b.x, nloc, nx); b.st[0] = nloc; b.st[1] = nx; }
        const unsigned old = xb_add(&bar[XB_XSUB(b.x)], 1u);
        const unsigned gen = old / nloc;
        if (old + 1u == (gen + 1u) * nloc) {
            __builtin_amdgcn_fence(__ATOMIC_RELEASE, "agent");
            asm volatile("s_waitcnt vmcnt(0)" ::: "memory");
            const unsigned og = xb_add(&bar[XB_TOP], 1u);
            const unsigned tg = og / nx;
            if (og + 1u == (tg + 1u) * nx) xb_add(&bar[XB_TOPGEN], 1u);
            else XB_SPIN(xb_ld(&bar[XB_TOPGEN]) == tg, bar);
            __builtin_amdgcn_fence(__ATOMIC_ACQUIRE, "agent");
            xb_add(&bar[XB_XGEN(b.x)], 1u);
            asm volatile("s_waitcnt vmcnt(0)" ::: "memory");
        } else {
            XB_SPIN(xb_ld(&bar[XB_XGEN(b.x)]) == gen, bar);
            __builtin_amdgcn_fence(__ATOMIC_ACQUIRE, "agent");
            asm volatile("s_waitcnt vmcnt(0)" ::: "memory");
        }
    }
    __syncthreads();
}
constexpr int NWAVES = 8;
constexpr int NB = 8, SEQ = 4096, DM = 1024, T = NB * SEQ;
constexpr int GW = 256, NIN = 2304, DFF = 2816, NE = 8, DFE = 3584, CONVW = 31;
constexpr int MOE_CHUNK_TILES = 64, MOE_NCHUNK = 5, MOE_MAX_ROWS = 264 * 256;
#ifndef MK_PER_PHASE
#define MK_PER_PHASE 0
#endif
constexpr int N_PHASES = 15 + MOE_NCHUNK;
#ifndef PROBE_DUP
#define PROBE_DUP 0ull
#endif
#define DUPN(k) (1 + (int)((PROBE_DUP >> (k)) & 1ull))
static_assert(MOE_CHUNK_TILES * MOE_NCHUNK * 256 >= MOE_MAX_ROWS, "MoE chunks cover every row tile");

constexpr size_t KiB = 1024, MiB = 1u << 20;
constexpr size_t WS_CTL = 0, CTL_ZERO_BYTES = 64 * KiB;
constexpr int CW_TMO = 0, CW_CODE = 1, CW_BAR = 4096, CW_ECNT = 8192;
constexpr size_t WS_TAB = 1 * MiB;
constexpr size_t WS_ROPEC = WS_TAB, WS_ROPED = WS_TAB + 256 * KiB, WS_MISC = WS_TAB + 384 * KiB, WS_SS0 = WS_TAB + 448 * KiB, WS_LSE = WS_TAB + 576 * KiB;
constexpr size_t WS_TOKE = WS_TAB + 2112 * KiB, WS_TOKG = WS_TAB + 2368 * KiB, WS_TOKP = WS_TAB + 2624 * KiB, WS_SSROW = WS_TAB + 2880 * KiB, WS_SST = WS_TAB + 3152 * KiB;
constexpr size_t WS_W = 4608 * KiB;
constexpr size_t SZ_WIN = (size_t)NIN * DM * 2, SZ_WOUT = (size_t)DM * DM * 2, SZ_W1 = (size_t)2 * DFF * DM * 2, SZ_W2 = (size_t)DM * DFF * 2, SZ_W1E = (size_t)2 * DFE * DM, SZ_W2E = (size_t)DM * DFE;
constexpr size_t WS_WIN = WS_W, WS_WOUT = WS_WIN + 2 * SZ_WIN, WS_W1 = WS_WOUT + 2 * SZ_WOUT, WS_W2 = WS_W1 + SZ_W1, WS_W1E = WS_W2 + SZ_W2, WS_W2E = WS_W1E + NE * SZ_W1E, WS_WEND = WS_W2E + NE * SZ_W2E;
constexpr size_t WS_ACT = 202 * MiB;
static_assert(WS_SSROW + (size_t)MOE_MAX_ROWS * 4 <= WS_SST && WS_SST + (size_t)T * 4 <= WS_W && WS_WEND <= WS_ACT, "d_ws map: tables / weights");
constexpr size_t SZ_TB = (size_t)T * 256 * 2;
constexpr size_t WS_XB = WS_ACT;
constexpr size_t WS_UB = WS_ACT + 64 * MiB;
constexpr size_t WS_QD = WS_UB + 7 * SZ_TB;
constexpr size_t WS_Y = WS_ACT + 208 * MiB;
constexpr size_t WS_OC = WS_ACT + 272 * MiB;
constexpr size_t WS_SSP = WS_OC;
constexpr size_t WS_XB8 = WS_ACT + 64 * MiB;
constexpr size_t WS_HID = WS_ACT + 64 * MiB;
constexpr size_t WS_Y2 = WS_ACT + 242 * MiB;
constexpr size_t WS_HS = WS_ACT + 176 * MiB;
constexpr size_t WS_HIDE = WS_ACT + 64 * MiB, SZ_HIDE = (size_t)MOE_CHUNK_TILES * 256 * DFE;
constexpr size_t WS_END = WS_ACT + 320 * MiB;
static_assert(WS_QD + (size_t)T * 512 * 2 == WS_Y && WS_Y + (size_t)T * 1024 * 2 == WS_OC && WS_OC + 3 * SZ_TB == WS_END, "d_ws map: activations");
static_assert(WS_HID + (size_t)T * DFF * 2 <= WS_OC && WS_Y2 + (size_t)MOE_MAX_ROWS * 1024 <= WS_END && WS_HS + (size_t)MOE_MAX_ROWS * 1024 <= WS_Y2 && WS_HIDE + 2 * SZ_HIDE <= WS_HS && WS_XB + (size_t)T * 2048 <= WS_HIDE, "d_ws map: FFN overlays");

constexpr int RING_OFF = 0, RING_BYTES = 131072;
constexpr int LDSCTL_OFF = RING_BYTES, MISC_OFF = LDSCTL_OFF + 320;
constexpr int LDS_BYTES = 147456;
__device__ __forceinline__ float bf2f(unsigned short b) { return __uint_as_float((unsigned)b << 16); }
__device__ __forceinline__ float wave_sum(float v) {
#pragma unroll
    for (int o = 1; o < 64; o <<= 1) v += __shfl_xor(v, o);
    return v;
}
typedef float f32x16v __attribute__((ext_vector_type(16)));
typedef short s16x4v __attribute__((ext_vector_type(4)));
typedef unsigned v2u __attribute__((ext_vector_type(2)));

__device__ __forceinline__ const float* inp(const LAS unsigned char* lds, int i) {
    int i_ = i; asm volatile("" : "+s"(i_));
    const LAS unsigned* p = (const LAS unsigned*)(lds + LDSCTL_OFF) + 2 * i_;
    const unsigned lo = __builtin_amdgcn_readfirstlane(p[0]), hi = __builtin_amdgcn_readfirstlane(p[1]);
    return (const float*)(const GAS float*)(((unsigned long long)hi << 32) | lo);
}
__device__ __forceinline__ void tr_item(const float* W, int ldw, const float* gk, bf16* WT, int ldt, int k0, int sc0, int dr0, bool hperm, LAS float* scr, int lane) {
    { float v[32];
#pragma unroll
      for (int i = 0; i < 32; ++i) v[i] = W[(size_t)(k0 + 2 * i + (lane >> 5)) * ldw + sc0 + (lane & 31)];
      if (gk) {
#pragma unroll
          for (int i = 0; i < 32; ++i) v[i] *= gk[k0 + 2 * i + (lane >> 5)]; }
#pragma unroll
      for (int i = 0; i < 32; ++i) scr[(2 * i + (lane >> 5)) * 33 + (lane & 31)] = v[i]; }
    LDS_WAIT(); asm volatile("" ::: "memory");
    const int c = lane & 7;
#pragma unroll
    for (int j = 0; j < 4; ++j) { const int n = (lane >> 3) + 8 * j; int ns = n; if (hperm && n < 16) ns = ((n >> 2) & 1) * 8 + (n >> 3) * 4 + (n & 3);
        const LAS float* s = scr + (8 * c) * 33 + ns;
        v4u o; o.x = pk2(s[0 * 33], s[1 * 33]); o.y = pk2(s[2 * 33], s[3 * 33]); o.z = pk2(s[4 * 33], s[5 * 33]); o.w = pk2(s[6 * 33], s[7 * 33]);
        *(GAS v4u*)(WT + (size_t)(dr0 + n) * ldt + k0 + 8 * c) = o; }
    LDS_WAIT(); asm volatile("" ::: "memory");
}
__device__ __forceinline__ void tr_item8(const float* W, int ldw, const float* gk, unsigned char* WT, int ldt, int k0, int sc0, int dr0, LAS float* scr, int lane) {
    { float v[32];
#pragma unroll
      for (int i = 0; i < 32; ++i) v[i] = W[(size_t)(k0 + 2 * i + (lane >> 5)) * ldw + sc0 + (lane & 31)];
      if (gk) {
#pragma unroll
          for (int i = 0; i < 32; ++i) v[i] *= gk[k0 + 2 * i + (lane >> 5)]; }
#pragma unroll
      for (int i = 0; i < 32; ++i) scr[(2 * i + (lane >> 5)) * 33 + (lane & 31)] = v[i] * pg8::F8_WGT; }
    LDS_WAIT(); asm volatile("" ::: "memory");
    const int c = lane & 7;
#pragma unroll
    for (int j = 0; j < 4; ++j) { const int n = (lane >> 3) + 8 * j; const LAS float* s = scr + (8 * c) * 33 + n;
        v2u o; o.x = pg8::pack4_fp8(s[0 * 33], s[1 * 33], s[2 * 33], s[3 * 33]); o.y = pg8::pack4_fp8(s[4 * 33], s[5 * 33], s[6 * 33], s[7 * 33]);
        *(GAS v2u*)(WT + (size_t)(dr0 + n) * ldt + k0 + 8 * c) = o; }
    LDS_WAIT(); asm volatile("" ::: "memory");
}
__device__ __forceinline__ void tr_glu_item16(const float* Wg, const float* Wu, int F, const float* gk, bf16* WT, int item, LAS float* scr, int lane) {
    const int nblk = 2 * F / 32, kb = item / nblk, nb = item % nblk, tile = nb >> 3, j = nb & 7;
    tr_item(j < 4 ? Wg : Wu, F, gk, WT, DM, 64 * kb, 128 * tile + 32 * (j & 3), 32 * nb, false, scr, lane);
}
__device__ __forceinline__ void tr_glu_item(const float* Wg, const float* Wu, int F, const float* gk, unsigned char* WT, int item, LAS float* scr, int lane) {
    const int nblk = 2 * F / 32, kb = item / nblk, nb = item % nblk, tile = nb >> 3, j = nb & 7;
    tr_item8(j < 4 ? Wg : Wu, F, gk, WT, DM, 64 * kb, 128 * tile + 32 * (j & 3), 32 * nb, scr, lane);
}
#define IN_(i) inp(lds, (i))
struct TrP { const float* W; const float* gk; unsigned char* WT; int ldw, ldt, k0, sc0, dr0, mode; };
__device__ __forceinline__ TrP tr_glu(const float* Wg, const float* Wu, int F, const float* gk, unsigned char* WT, int item, int mode) {
    const int nblk = 2 * F / 32, kb = item / nblk, nb = item % nblk, tile = nb >> 3, j = nb & 7;
    return TrP{j < 4 ? Wg : Wu, gk, WT, F, DM, 64 * kb, 128 * tile + 32 * (j & 3), 32 * nb, mode};
}
__device__ __forceinline__ TrP tr_decode(int it, unsigned char* ws, const LAS unsigned char* lds) {
    constexpr int I_IN = 16 * 72, I_OUT = 8 * 32, I_F1 = 16 * (2 * DFF / 32), I_F2 = (DFF / 64) * 32, I_E1 = 16 * (2 * DFE / 32), I_E2 = (DFE / 64) * 32;
    int r = it;
    if (r < 2 * I_IN) { const int l = r / I_IN; r -= l * I_IN; const int kb = r / 72, nb = r % 72, tile = nb >> 3, j = nb & 7;
        int sc0; if (tile == 0) sc0 = (j < 4) ? 32 * j : 256 + 32 * (j - 4); else if (tile == 1) sc0 = (j < 4) ? 128 + 32 * j : 384 + 32 * (j - 4); else sc0 = 256 * tile + 32 * j;
        return TrP{IN_(2) + (size_t)l * DM * NIN, IN_(1) + l * DM, ws + WS_WIN + l * SZ_WIN, NIN, DM, 64 * kb, sc0, 32 * nb, ((tile == 3 || tile == 4) && ((j & 1) == 0)) ? 1 : 0}; }
    r -= 2 * I_IN;
    if (r < 2 * I_OUT) { const int l = r / I_OUT; r -= l * I_OUT; const int kb = 8 + r / 32, nb = r % 32;
        return TrP{IN_(12) + (size_t)l * DM * DM, nullptr, ws + WS_WOUT + l * SZ_WOUT, DM, DM, 64 * kb, 32 * nb, 32 * nb, 0}; }
    r -= 2 * I_OUT;
    if (r < I_F1) return tr_glu(IN_(14), IN_(15), DFF, IN_(13), ws + WS_W1, r, 0);
    r -= I_F1;
    if (r < I_F2) { const int kb = r / 32, nb = r % 32; return TrP{IN_(16), nullptr, ws + WS_W2, DM, DFF, 64 * kb, 32 * nb, 32 * nb, 0}; }
    r -= I_F2;
    if (r < NE * I_E1) { const int e = r / I_E1; r -= e * I_E1; return tr_glu(IN_(18) + (size_t)e * DM * DFE, IN_(19) + (size_t)e * DM * DFE, DFE, IN_(13) + DM, ws + WS_W1E + e * SZ_W1E, r, 2); }
    r -= NE * I_E1;
    { const int e = r / I_E2; r -= e * I_E2; const int kb = r / 32, nb = r % 32; return TrP{IN_(20) + (size_t)e * DFE * DM, nullptr, ws + WS_W2E + e * SZ_W2E, DM, DFE, 64 * kb, 32 * nb, 32 * nb, 2}; }
}
__device__ __forceinline__ void tr_load(const TrP& p, float (&v)[32], f32x4 (&g)[2], int lane) {
#pragma unroll
    for (int i = 0; i < 8; ++i) { const f32x4 q = __builtin_nontemporal_load((const f32x4*)(p.W + (size_t)(p.k0 + 8 * i + (lane >> 3)) * p.ldw + p.sc0 + 4 * (lane & 7)));
        v[4 * i] = q.x; v[4 * i + 1] = q.y; v[4 * i + 2] = q.z; v[4 * i + 3] = q.w; }
    if (p.gk) { g[0] = *(const f32x4*)(p.gk + p.k0 + 8 * (lane & 7)); g[1] = *(const f32x4*)(p.gk + p.k0 + 8 * (lane & 7) + 4); }
    else { g[0] = (f32x4){1.f, 1.f, 1.f, 1.f}; g[1] = g[0]; }
}
__device__ __forceinline__ void tr_finish(const TrP& p, const float (&v)[32], const f32x4 (&g)[2], LAS float* scr, int lane) {
#pragma unroll
    for (int i = 0; i < 8; ++i)
#pragma unroll
        for (int q = 0; q < 4; ++q) scr[(8 * i + (lane >> 3)) * 33 + 4 * (lane & 7) + q] = v[4 * i + q];
    LDS_WAIT(); asm volatile("" ::: "memory");
    const int c = lane & 7;
#pragma unroll
    for (int j = 0; j < 4; ++j) { const int n = (lane >> 3) + 8 * j; int ns = n; if (p.mode == 1 && n < 16) ns = ((n >> 2) & 1) * 8 + (n >> 3) * 4 + (n & 3);
        const LAS float* s = scr + (8 * c) * 33 + ns;
        const float a0 = s[0 * 33] * g[0].x, a1 = s[1 * 33] * g[0].y, a2 = s[2 * 33] * g[0].z, a3 = s[3 * 33] * g[0].w, a4 = s[4 * 33] * g[1].x, a5 = s[5 * 33] * g[1].y, a6 = s[6 * 33] * g[1].z, a7 = s[7 * 33] * g[1].w;
        if (p.mode == 2) { v2u o; o.x = pg8::pack4_fp8(a0 * pg8::F8_WGT, a1 * pg8::F8_WGT, a2 * pg8::F8_WGT, a3 * pg8::F8_WGT); o.y = pg8::pack4_fp8(a4 * pg8::F8_WGT, a5 * pg8::F8_WGT, a6 * pg8::F8_WGT, a7 * pg8::F8_WGT);
            __builtin_nontemporal_store(o, (GAS v2u*)(p.WT + (size_t)(p.dr0 + n) * p.ldt + p.k0 + 8 * c)); }
        else { v4u o; o.x = pk2(a0, a1); o.y = pk2(a2, a3); o.z = pk2(a4, a5); o.w = pk2(a6, a7); *(GAS v4u*)((bf16*)p.WT + (size_t)(p.dr0 + n) * p.ldt + p.k0 + 8 * c) = o; } }
    LDS_WAIT(); asm volatile("" ::: "memory");
}
constexpr int TR_N0 = 2 * (16 * 72) + 2 * (8 * 32) + 16 * (2 * DFF / 32) + (DFF / 64) * 32;
constexpr int TR_NALL = TR_N0 + NE * (16 * (2 * DFE / 32)) + NE * ((DFE / 64) * 32);
__device__ __forceinline__ void tr_loop(unsigned char* ws, const LAS unsigned char* lds, int first, int count, int widx, int nw, LAS float* scr, int lane) {
    TrP pa, pb; float va[32], vb[32]; f32x4 ga[2], gb[2];
    int it = widx; bool ha = it < count; if (ha) { pa = tr_decode(first + it, ws, lds); tr_load(pa, va, ga, lane); }
    while (ha) {
        const int itb = it + nw; const bool hb = itb < count; if (hb) { pb = tr_decode(first + itb, ws, lds); tr_load(pb, vb, gb, lane); }
        tr_finish(pa, va, ga, scr, lane);
        if (!hb) break;
        it = itb + nw; ha = it < count; if (ha) { pa = tr_decode(first + it, ws, lds); tr_load(pa, va, ga, lane); }
        tr_finish(pb, vb, gb, scr, lane);
    }
}
__device__ __forceinline__ void p0_prologue(unsigned char* ws, LAS unsigned char* lds, int vcu, int G, int tid, int lane, int wave) {
    LAS float* scr = (LAS float*)(lds + RING_OFF + wave * 16384);
    const float* x = IN_(0);
    constexpr int I_IN = 16 * 72, I_OUT = 8 * 32, I_F1 = 16 * (2 * DFF / 32), I_F2 = (DFF / 64) * 32, I_E1 = 16 * (2 * DFE / 32), I_E2 = (DFE / 64) * 32;
    constexpr int NITEMS = 2 * I_IN + 2 * I_OUT + I_F1 + I_F2 + NE * I_E1 + NE * I_E2; static_assert(NITEMS == TR_NALL, "item count");
    if (wave < 2) for (int fi = vcu; fi < 256; fi += G) { const int l = fi >> 7, kb = ((fi >> 2) & 31) + 32 * wave, n4 = (fi & 3) * 64 + lane;
          f32x4 a[8];
#pragma unroll
          for (int i = 0; i < 8; ++i) a[i] = (f32x4){0.f, 0.f, 0.f, 0.f};
          if (kb < 32) { const float* pw = IN_(7) + (size_t)l * GW * GW + (size_t)kb * 8 * GW; const float* wo = IN_(12) + (size_t)l * DM * DM + 4 * n4;
#pragma unroll 1
              for (int j = 0; j < 256; j += 4) { f32x4 w[4];
#pragma unroll
                  for (int jj = 0; jj < 4; ++jj) w[jj] = *(const f32x4*)(wo + (size_t)(j + jj) * DM);
#pragma unroll
                  for (int i = 0; i < 8; ++i) { const f32x4 pv = *(const f32x4*)(pw + i * GW + j); a[i] += pv.x * w[0]; a[i] += pv.y * w[1]; a[i] += pv.z * w[2]; a[i] += pv.w * w[3]; } } }
          else { const int g = (kb - 32) >> 3, p0 = ((kb - 32) & 7) * 8; const float* pw = IN_(8) + (size_t)l * 4 * 64 * 64 + (size_t)(g * 64 + p0) * 64; const float* sc = IN_(9) + l * GW + 64 * g;
              const float* wo = IN_(12) + (size_t)l * DM * DM + (size_t)(256 + 64 * g) * DM + 4 * n4;
#pragma unroll 1
              for (int q = 0; q < 64; q += 4) { f32x4 w[4]; const f32x4 s4 = *(const f32x4*)(sc + q);
#pragma unroll
                  for (int jj = 0; jj < 4; ++jj) w[jj] = *(const f32x4*)(wo + (size_t)(q + jj) * DM) * s4[jj];
#pragma unroll
                  for (int i = 0; i < 8; ++i) { const f32x4 pv = *(const f32x4*)(pw + i * 64 + q); a[i] += pv.x * w[0]; a[i] += pv.y * w[1]; a[i] += pv.z * w[2]; a[i] += pv.w * w[3]; } } }
          bf16* wt = (bf16*)(ws + WS_WOUT + l * SZ_WOUT) + (size_t)(4 * n4) * DM + kb * 8;
          { v4u o0, o1, o2, o3; o0.x = pk2(a[0].x, a[1].x); o0.y = pk2(a[2].x, a[3].x); o0.z = pk2(a[4].x, a[5].x); o0.w = pk2(a[6].x, a[7].x);
            o1.x = pk2(a[0].y, a[1].y); o1.y = pk2(a[2].y, a[3].y); o1.z = pk2(a[4].y, a[5].y); o1.w = pk2(a[6].y, a[7].y);
            o2.x = pk2(a[0].z, a[1].z); o2.y = pk2(a[2].z, a[3].z); o2.z = pk2(a[4].z, a[5].z); o2.w = pk2(a[6].z, a[7].z);
            o3.x = pk2(a[0].w, a[1].w); o3.y = pk2(a[2].w, a[3].w); o3.z = pk2(a[4].w, a[5].w); o3.w = pk2(a[6].w, a[7].w);
            *(GAS v4u*)(wt) = o0; *(GAS v4u*)(wt + DM) = o1; *(GAS v4u*)(wt + 2 * DM) = o2; *(GAS v4u*)(wt + 3 * DM) = o3; } }
    if (wave == 1) { float* rc = (float*)(ws + WS_ROPEC); float* rd = (float*)(ws + WS_ROPED);
      for (int it = vcu * 64 + lane; it < SEQ * 12; it += G * 64) { const int pos = it / 12, i = it % 12;
          const float inv = (i < 8) ? powf(500000.0f, -(float)(2 * i) / 16.0f) : powf(500000.0f, -(float)(2 * (i - 8)) / 8.0f);
          const float ang = (float)pos * inv; double rv = (double)ang * 0.15915494309189535; rv -= floor(rv); const float fr_ = (float)rv;
          const float cs = __builtin_amdgcn_cosf(fr_), sn = __builtin_amdgcn_sinf(fr_);
          if (i < 8) { rc[pos * 16 + (i >> 2) * 8 + (i & 3)] = cs; rc[pos * 16 + (i >> 2) * 8 + 4 + (i & 3)] = sn; }
          else { const int i2 = i - 8; rd[pos * 8 + i2] = cs; rd[pos * 8 + 4 + i2] = sn; } } }
    if (wave == 2 && vcu < 2 && lane == 0) { const int l = vcu; const float* lv = IN_(10) + l * 128; float s01 = 0.f, s23 = 0.f; for (int j = 0; j < 32; ++j) { s01 += lv[j] * lv[32 + j]; s23 += lv[64 + j] * lv[96 + j]; }
          const float li = 0.8f - 0.6f * expf(-0.3f * (float)l); float* mi = (float*)(ws + WS_MISC); mi[2 * l] = expf(s01) - expf(s23) + li; mi[2 * l + 1] = 1.0f - li; }
    if (wave > 0) tr_loop(ws, lds, 0, TR_N0, vcu + G * (NWAVES - 1 - wave), G * (NWAVES - 1), scr, lane);
    { bf16* xb = (bf16*)(ws + WS_XB); float* ss0 = (float*)(ws + WS_SS0);
      if (wave > 0) for (int m = 2 * (NWAVES - 1 - wave) * G + vcu; m < T; m += 2 * (NWAVES - 1) * G) { const int m2 = m + G;
          const GAS f32x4* xr = (const GAS f32x4*)(x + (size_t)m * DM) + lane; const GAS f32x4* xr2 = (const GAS f32x4*)(x + (size_t)(m2 < T ? m2 : m) * DM) + lane;
          f32x4 v[4], w2[4];
#pragma unroll
          for (int j = 0; j < 4; ++j) { v[j] = __builtin_nontemporal_load(xr + 64 * j); w2[j] = __builtin_nontemporal_load(xr2 + 64 * j); }
          GAS v2u* o8 = (GAS v2u*)(xb + (size_t)m * DM) + lane; GAS v2u* o82 = (GAS v2u*)(xb + (size_t)(m2 < T ? m2 : m) * DM) + lane; float s = 0.f, s2 = 0.f;
#pragma unroll
          for (int j = 0; j < 4; ++j) { s += (v[j].x * v[j].x + v[j].y * v[j].y) + (v[j].z * v[j].z + v[j].w * v[j].w); s2 += (w2[j].x * w2[j].x + w2[j].y * w2[j].y) + (w2[j].z * w2[j].z + w2[j].w * w2[j].w);
              v2u w; w.x = pk2(v[j].x, v[j].y); w.y = pk2(v[j].z, v[j].w); o8[64 * j] = w; if (m2 < T) { v2u q; q.x = pk2(w2[j].x, w2[j].y); q.y = pk2(w2[j].z, w2[j].w); o82[64 * j] = q; } }
          s = wave_sum(s); s2 = wave_sum(s2); if (lane == 0) { ss0[m] = s; if (m2 < T) ss0[m2] = s2; } } }
}
constexpr int CK_PITCH = 144, CV_OFF = 384 * CK_PITCH, CV_HALF = 384 * 64, CS_OFF = CV_OFF + 2 * CV_HALF;
static_assert(CS_OFF + NWAVES * 128 <= RING_BYTES, "dilated-attention LDS");
__device__ __forceinline__ s16x4v vtr16(const LAS unsigned char* p) { return __builtin_bit_cast(s16x4v, __builtin_amdgcn_ds_read_tr16_b64_v4i16((LAS s16x4v*)p)); }
__device__ __forceinline__ int crow16(int r, int hi) { return (r & 3) + 8 * (r >> 2) + 4 * hi; }
__device__ __forceinline__ void dil_load(int uc, const bf16* KC, const bf16* VC, int tid, v4u (&kr)[6], v4u (&vr)[6]) {
    const int br = uc >> 9, rem = uc & 511, bh = rem >> 4, blk = rem & 15, b = bh >> 2, h = bh & 3;
    const int sh = 2 * br, dil = 1 << sh, r = blk & (dil - 1), m0 = (blk >> sh) << 8;
    const size_t tok0 = (size_t)b * SEQ;
#pragma unroll
    for (int it = 0; it < 6; ++it) { const int i = tid + it * (NWAVES * 64), j = i >> 3, ch = i & 7, m = m0 - 128 + j, mm = m < 0 ? 0 : m;
        const size_t off = (tok0 + ((size_t)mm << sh) + r) * 256 + h * 64 + ch * 8; kr[it] = *(const GAS v4u*)(KC + off); vr[it] = *(const GAS v4u*)(VC + off); }
}
__device__ __forceinline__ void dil_stage(int uc, const v4u (&kr)[6], const v4u (&vr)[6], LAS unsigned char* lds, int tid) {
    const int br = uc >> 9, blk = uc & 15, sh = 2 * br, m0 = (blk >> sh) << 8;
#pragma unroll
    for (int it = 0; it < 6; ++it) { const int i = tid + it * (NWAVES * 64), j = i >> 3, ch = i & 7, m = m0 - 128 + j;
        const v4u z = (v4u){0u, 0u, 0u, 0u};
        *(LAS v4u*)(lds + j * CK_PITCH + ch * 16) = (m >= 0) ? kr[it] : z;
        *(LAS v4u*)(lds + CV_OFF + (ch >> 2) * CV_HALF + j * 64 + (ch & 3) * 16) = (m >= 0) ? vr[it] : z; }
}
__device__ __forceinline__ void dil_loadq(int uc, const bf16* QC, int lane, int wid, bf16x8 (&qr)[4]) {
    const int br = uc >> 9, rem = uc & 511, bh = rem >> 4, blk = rem & 15, b = bh >> 2, h = bh & 3;
    const int sh = 2 * br, dil = 1 << sh, r = blk & (dil - 1), m0 = (blk >> sh) << 8, r32 = lane & 31, hi = lane >> 5;
    const size_t qtok = (size_t)b * SEQ + ((size_t)(m0 + 32 * wid + r32) << sh) + r;
#pragma unroll
    for (int d0 = 0; d0 < 4; ++d0) qr[d0] = *(const GAS bf16x8*)(QC + qtok * 256 + h * 64 + d0 * 16 + hi * 8);
}
__device__ __forceinline__ void dil_compute(int uc, const bf16x8 (&qr)[4], bf16* OCb, float* LSEb, LAS unsigned char* lds, int lane, int wid, int ucn, const bf16* KC, const bf16* VC, int tid, v4u (&kr)[6], v4u (&vr)[6]) {
    const int br = uc >> 9, rem = uc & 511, bh = rem >> 4, blk = rem & 15, b = bh >> 2, h = bh & 3;
    const int sh = 2 * br, dil = 1 << sh, r = blk & (dil - 1), m0 = (blk >> sh) << 8;
    const size_t tok0 = (size_t)b * SEQ;
    bf16* OC = OCb + (size_t)br * T * 256; float* LSE = LSEb + (size_t)br * T * 4;
    const int r32 = lane & 31, hi = lane >> 5;
    const size_t qtok = tok0 + ((size_t)(m0 + 32 * wid + r32) << sh) + r;
    f32x16v S[5];
    const LAS unsigned char* kbase = lds + (32 * wid + r32) * CK_PITCH + hi * 16;
#pragma unroll
    for (int jb = 0; jb < 5; ++jb) { f32x16v a = {};
#pragma unroll
        for (int d0 = 0; d0 < 4; ++d0) { const bf16x8 kf = *(const LAS bf16x8*)(kbase + jb * 32 * CK_PITCH + d0 * 32); a = __builtin_amdgcn_mfma_f32_32x32x16_bf16(kf, qr[d0], a, 0, 0, 0); }
        S[jb] = a; }
    const int kmin = (m0 == 0) ? (128 - 32 * wid) : 0;
    { const int lo0 = r32 > kmin ? r32 : kmin;
#pragma unroll
      for (int rg = 0; rg < 16; ++rg) { const int c = crow16(rg, hi); if (c < lo0) S[0][rg] = -INFINITY; if (c > r32) S[4][rg] = -INFINITY; }
      if (kmin > 32) {
#pragma unroll
          for (int jb = 1; jb < 4; ++jb)
#pragma unroll
              for (int rg = 0; rg < 16; ++rg) { if (32 * jb + crow16(rg, hi) < kmin) S[jb][rg] = -INFINITY; }
      } }
    __builtin_amdgcn_sched_barrier(0);
    float mx = -INFINITY;
#pragma unroll
    for (int jb = 0; jb < 5; ++jb)
#pragma unroll
        for (int rg = 0; rg < 16; ++rg) mx = fmaxf(mx, S[jb][rg]);
    { auto rr = __builtin_amdgcn_permlane32_swap(__float_as_uint(mx), __float_as_uint(mx), false, false); mx = fmaxf(__uint_as_float(rr[0]), __uint_as_float(rr[1])); }
    float l = 0.f; pg8::u32x4 pw[5][2];
#pragma unroll
    for (int jb = 0; jb < 5; ++jb) {
#pragma unroll
        for (int rg = 0; rg < 16; ++rg) { const float p = __builtin_amdgcn_exp2f(S[jb][rg] - mx); S[jb][rg] = p; l += p; }
#pragma unroll
        for (int s2 = 0; s2 < 2; ++s2) { pw[jb][s2].x = pg8::cvt_pk_bf16(S[jb][8 * s2 + 0], S[jb][8 * s2 + 1]); pw[jb][s2].y = pg8::cvt_pk_bf16(S[jb][8 * s2 + 2], S[jb][8 * s2 + 3]);
            pw[jb][s2].z = pg8::cvt_pk_bf16(S[jb][8 * s2 + 4], S[jb][8 * s2 + 5]); pw[jb][s2].w = pg8::cvt_pk_bf16(S[jb][8 * s2 + 6], S[jb][8 * s2 + 7]); } }
    { auto rr = __builtin_amdgcn_permlane32_swap(__float_as_uint(l), __float_as_uint(l), false, false); l = __uint_as_float(rr[0]) + __uint_as_float(rr[1]); }
    if (ucn >= 0) dil_load(ucn, KC, VC, tid, kr, vr);
    f32x16v o0 = {}, o1 = {};
    const LAS unsigned char* vbase = lds + CV_OFF + ((lane >> 4) & 1) * 32 + (lane & 3) * 8 + (32 * wid + 4 * hi + ((lane & 15) >> 2)) * 64;
#pragma unroll
    for (int jb = 0; jb < 5; ++jb)
#pragma unroll
        for (int s2 = 0; s2 < 2; ++s2) {
            const bf16x8 pa = __builtin_bit_cast(bf16x8, pw[jb][s2]);
            const LAS unsigned char* vp = vbase + (32 * jb + 16 * s2) * 64;
            const s16x4v a0 = vtr16(vp), a1 = vtr16(vp + 512), c0 = vtr16(vp + CV_HALF), c1 = vtr16(vp + CV_HALF + 512);
            const bf16x8 v0 = (bf16x8){a0[0], a0[1], a0[2], a0[3], a1[0], a1[1], a1[2], a1[3]}, v1 = (bf16x8){c0[0], c0[1], c0[2], c0[3], c1[0], c1[1], c1[2], c1[3]};
            o0 = __builtin_amdgcn_mfma_f32_32x32x16_bf16(v0, pa, o0, 0, 0, 0); o1 = __builtin_amdgcn_mfma_f32_32x32x16_bf16(v1, pa, o1, 0, 0, 0); }
    if (hi == 0) LSE[qtok * 4 + h] = mx + __builtin_amdgcn_logf(l);
    { const float il = __builtin_amdgcn_rcpf(l);
      bf16* op = OC + qtok * 256 + h * 64 + 8 * hi;
#pragma unroll
      for (int hf = 0; hf < 2; ++hf)
#pragma unroll
          for (int kp = 0; kp < 4; kp += 2) { const f32x16v o = hf ? o1 : o0;
              const unsigned ax = pg8::cvt_pk_bf16(o[4 * kp] * il, o[4 * kp + 1] * il), ay = pg8::cvt_pk_bf16(o[4 * kp + 2] * il, o[4 * kp + 3] * il);
              const unsigned bx = pg8::cvt_pk_bf16(o[4 * kp + 4] * il, o[4 * kp + 5] * il), by = pg8::cvt_pk_bf16(o[4 * kp + 6] * il, o[4 * kp + 7] * il);
              unsigned ax_ = ax, ay_ = ay, bx_ = bx, by_ = by; asm volatile("s_nop 1" : "+v"(ax_), "+v"(ay_), "+v"(bx_), "+v"(by_));
              const auto r0 = __builtin_amdgcn_permlane32_swap(ax_, bx_, false, false); const auto r1 = __builtin_amdgcn_permlane32_swap(ay_, by_, false, false);
              v4u w; w.x = r0[0]; w.y = r1[0]; w.z = r0[1]; w.w = r1[1];
              *(GAS v4u*)(op + hf * 32 + 8 * kp) = w; } }
    __syncthreads();
}

template <int W> __device__ __forceinline__ void pool_run(const float (&pin)[47], int sbase, bf16* yo) {
#pragma unroll
    for (int i = 0; i < 32; ++i) { float s = 0.f;
#pragma unroll
        for (int j = 0; j < W; ++j) s += pin[15 + i - j];
        const int pos = sbase + i; const float cnt = (float)((pos + 1 < W) ? pos + 1 : W);
        yo[(size_t)i * DM] = (bf16)f2bf(s / cnt - pin[15 + i]); }
}
__device__ __forceinline__ void ab_unit(int unit, const float* dww, const float* dwb, const float* lng, const float* lnb, const bf16* Z, const bf16* UBp, bf16* Y, LAS unsigned char* lds, int tid, int lane, int wid) {
    const int b = unit >> 6, s0 = (unit & 63) * 64, c = tid & 255, half = tid >> 8, sbase = s0 + 32 * half;
    const size_t tok0 = (size_t)b * SEQ;
    LAS float* cv = (LAS float*)lds;
    const f32x4 g4 = *(const f32x4*)(lng + 4 * lane), b4 = *(const f32x4*)(lnb + 4 * lane);
    float pin[47];
    { float w[CONVW];
#pragma unroll
      for (int j = 0; j < CONVW; ++j) w[j] = dww[j * GW + c];
      const float bias = dwb[c];
      float zin[62];
#pragma unroll
      for (int i = 0; i < 62; ++i) { const int s = sbase - 30 + i; zin[i] = bf2f(Z[(tok0 + (s >= 0 ? s : 0)) * 256 + c]); }
#pragma unroll
      for (int i = 0; i < 47; ++i) { const int s = sbase - 15 + i; pin[i] = bf2f(UBp[(tok0 + (s >= 0 ? s : 0)) * 256 + c]); }
      if (sbase < 30) {
#pragma unroll
          for (int i = 0; i < 62; ++i) zin[i] = (sbase - 30 + i >= 0) ? zin[i] : 0.f; }
#pragma unroll
      for (int i = 0; i < 32; ++i) { float a = bias;
#pragma unroll
          for (int j = 0; j < CONVW; ++j) a += w[j] * zin[i + j];
          cv[(32 * half + i) * 256 + c] = a; } }
    {
      if (sbase < 15) {
#pragma unroll
          for (int i = 0; i < 47; ++i) pin[i] = (sbase - 15 + i >= 0) ? pin[i] : 0.f; }
      bf16* yo = Y + (tok0 + sbase) * DM + 256 + c;
      const int g = (c >> 6);
      if (g == 0) pool_run<2>(pin, sbase, yo); else if (g == 1) pool_run<4>(pin, sbase, yo); else if (g == 2) pool_run<8>(pin, sbase, yo); else pool_run<16>(pin, sbase, yo); }
    __syncthreads();
    {
#pragma unroll
      for (int pp = 0; pp < 8; ++pp) { const int pos = 8 * wid + pp; const f32x4 v = *(const LAS f32x4*)(cv + pos * 256 + 4 * lane);
          const float mu = wave_sum((v.x + v.y) + (v.z + v.w)) * (1.0f / 256.0f); const f32x4 d = v - mu;
          const float var = wave_sum((d.x * d.x + d.y * d.y) + (d.z * d.z + d.w * d.w)) * (1.0f / 256.0f); const float rs = 1.0f / sqrtf(var + 1e-5f);
          f32x4 y = d * rs * g4 + b4; y.x *= pg8::sigm(y.x); y.y *= pg8::sigm(y.y); y.z *= pg8::sigm(y.z); y.w *= pg8::sigm(y.w);
          v2u w; w.x = pg8::cvt_pk_bf16(y.x, y.y); w.y = pg8::cvt_pk_bf16(y.z, y.w);
          *(GAS v2u*)(Y + (tok0 + s0 + pos) * DM + 4 * lane) = w; } }
    __syncthreads();
}

__device__ __forceinline__ void comb_phase(const bf16* OC, const float* LSE, const bf16* OD, bf16* Y, const float* dg, float lam, float omli, int gw, int NGW, int lane) {
    const int h = lane >> 4, d4 = (lane & 15) * 4; const f32x4 g4 = *(const f32x4*)(dg + d4);
    constexpr int U = 4;
    for (int t0 = gw; t0 < T; t0 += U * NGW) {
        float l0[U], l1[U], l2[U]; v2u a[U], bq[U], cq[U];
#pragma unroll
        for (int u = 0; u < U; ++u) { const int t = (t0 + u * NGW < T) ? t0 + u * NGW : t0;
            l0[u] = LSE[(size_t)t * 4 + h]; l1[u] = LSE[((size_t)T + t) * 4 + h]; l2[u] = LSE[((size_t)2 * T + t) * 4 + h];
            a[u] = *(const GAS v2u*)(OC + (size_t)t * 256 + 4 * lane); bq[u] = *(const GAS v2u*)(OC + ((size_t)T + t) * 256 + 4 * lane); cq[u] = *(const GAS v2u*)(OC + ((size_t)2 * T + t) * 256 + 4 * lane); }
#pragma unroll
        for (int u = 0; u < U; ++u) { const int t = t0 + u * NGW; if (t < T) {
            { const float mx = fmaxf(fmaxf(l0[u], l1[u]), l2[u]);
              float w0 = __builtin_amdgcn_exp2f(l0[u] - mx), w1 = __builtin_amdgcn_exp2f(l1[u] - mx), w2 = __builtin_amdgcn_exp2f(l2[u] - mx); const float inv = 1.0f / (w0 + w1 + w2); w0 *= inv; w1 *= inv; w2 *= inv;
              const float y0 = w0 * __uint_as_float(a[u].x << 16) + w1 * __uint_as_float(bq[u].x << 16) + w2 * __uint_as_float(cq[u].x << 16);
              const float y1 = w0 * __uint_as_float(a[u].x & 0xffff0000u) + w1 * __uint_as_float(bq[u].x & 0xffff0000u) + w2 * __uint_as_float(cq[u].x & 0xffff0000u);
              const float y2 = w0 * __uint_as_float(a[u].y << 16) + w1 * __uint_as_float(bq[u].y << 16) + w2 * __uint_as_float(cq[u].y << 16);
              const float y3 = w0 * __uint_as_float(a[u].y & 0xffff0000u) + w1 * __uint_as_float(bq[u].y & 0xffff0000u) + w2 * __uint_as_float(cq[u].y & 0xffff0000u);
              v2u w; w.x = pg8::cvt_pk_bf16(y0, y1); w.y = pg8::cvt_pk_bf16(y2, y3); *(GAS v2u*)(Y + (size_t)t * DM + 512 + 4 * lane) = w; }
} }
    }
}

__device__ __forceinline__ void route_phase(const bf16* x, const float* g2, const float* router, unsigned char* ws, LAS unsigned char* lds, int vcu, int G, int tid, int lane, int wave, size_t dmy = 0, int dmyc = 0) {
    LAS float* rt = (LAS float*)lds; LAS int* cnt = (LAS int*)(lds + 32768); LAS int* base = cnt + 8;
    for (int i = tid; i < NE * DM; i += NWAVES * 64) { const int e = i >> 10, k = i & 1023; rt[i] = g2[k] * router[k * NE + e]; }
    if (tid < NE) cnt[tid] = 0;
    __syncthreads();
    const int gw = vcu * NWAVES + wave, NGW = G * NWAVES;
    int* toke = (int*)(ws + WS_TOKE + dmy); float* tokg = (float*)(ws + WS_TOKG + dmy); int* tokp = (int*)(ws + WS_TOKP + dmy); float* sst = (float*)(ws + WS_SST + dmy);
    constexpr int U = 2;
    v2u nx[U][4];
#pragma unroll
    for (int u = 0; u < U; ++u) { const int t = (gw + u * NGW < T) ? gw + u * NGW : 0; const GAS v2u* xr = (const GAS v2u*)(x + (size_t)t * DM) + lane;
#pragma unroll
        for (int j = 0; j < 4; ++j) nx[u][j] = xr[64 * j]; }
    for (int t0 = gw; t0 < T; t0 += U * NGW) {
        f32x4 xv[U][4]; float ss[U], a[U][NE];
#pragma unroll
        for (int u = 0; u < U; ++u)
#pragma unroll
            for (int j = 0; j < 4; ++j) { const v2u w = nx[u][j]; xv[u][j] = (f32x4){__uint_as_float(w.x << 16), __uint_as_float(w.x & 0xffff0000u), __uint_as_float(w.y << 16), __uint_as_float(w.y & 0xffff0000u)}; }
#pragma unroll
        for (int u = 0; u < U; ++u) { const int tn = t0 + U * NGW + u * NGW; const int t = (tn < T) ? tn : 0; const GAS v2u* xr = (const GAS v2u*)(x + (size_t)t * DM) + lane;
#pragma unroll
            for (int j = 0; j < 4; ++j) nx[u][j] = xr[64 * j]; }
#pragma unroll
        for (int u = 0; u < U; ++u) { ss[u] = 0.f;
#pragma unroll
            for (int e = 0; e < NE; ++e) a[u][e] = 0.f; }
#pragma unroll
        for (int j = 0; j < 4; ++j) {
#pragma unroll
            for (int e = 0; e < NE; ++e) { const f32x4 w = *(const LAS f32x4*)(rt + e * DM + 256 * j + 4 * lane);
#pragma unroll
                for (int u = 0; u < U; ++u) { const f32x4 v = xv[u][j]; a[u][e] += (v.x * w.x + v.y * w.y) + (v.z * w.z + v.w * w.w); } }
#pragma unroll
            for (int u = 0; u < U; ++u) { const f32x4 v = xv[u][j]; ss[u] += (v.x * v.x + v.y * v.y) + (v.z * v.z + v.w * v.w); } }
        float lg[U][NE];
#pragma unroll
        for (int u = 0; u < U; ++u) {
            const bool h5 = (lane & 32) != 0, h4 = (lane & 16) != 0, h3 = (lane & 8) != 0;
            float k4[4], k2[2], k1;
#pragma unroll
            for (int i = 0; i < 4; ++i) { const float send = h5 ? a[u][i] : a[u][4 + i], keep = h5 ? a[u][4 + i] : a[u][i]; k4[i] = keep + __shfl_xor(send, 32); }
#pragma unroll
            for (int i = 0; i < 2; ++i) { const float send = h4 ? k4[i] : k4[2 + i], keep = h4 ? k4[2 + i] : k4[i]; k2[i] = keep + __shfl_xor(send, 16); }
            { const float send = h3 ? k2[0] : k2[1], keep = h3 ? k2[1] : k2[0]; k1 = keep + __shfl_xor(send, 8); }
            k1 += __shfl_xor(k1, 4); k1 += __shfl_xor(k1, 2); k1 += __shfl_xor(k1, 1);
#pragma unroll
            for (int e = 0; e < NE; ++e) lg[u][e] = __builtin_bit_cast(float, __builtin_amdgcn_readlane(__builtin_bit_cast(int, k1), 8 * e));
#pragma unroll
            for (int o = 1; o < 64; o <<= 1) ss[u] += __shfl_xor(ss[u], o);
        }
#pragma unroll
        for (int u = 0; u < U; ++u) { const int t = t0 + u * NGW; if (t < T) {
            const float rs = 1.0f / sqrtf(ss[u] * (1.0f / 1024.0f) + 1e-5f);
            int i0 = 0; float v0 = lg[u][0];
#pragma unroll
            for (int e = 1; e < NE; ++e) if (lg[u][e] > v0) { v0 = lg[u][e]; i0 = e; }
            int i1 = -1; float v1 = -INFINITY;
#pragma unroll
            for (int e = 0; e < NE; ++e) if (e != i0 && lg[u][e] > v1) { v1 = lg[u][e]; i1 = e; }
            const float g0 = 1.0f / (1.0f + expf((v1 - v0) * rs)), g1 = 1.0f - g0;
            if (lane == 0) { const int r0 = __hip_atomic_fetch_add(cnt + i0, 1, __ATOMIC_RELAXED, __HIP_MEMORY_SCOPE_WORKGROUP), r1 = __hip_atomic_fetch_add(cnt + i1, 1, __ATOMIC_RELAXED, __HIP_MEMORY_SCOPE_WORKGROUP);
                toke[2 * t] = i0; toke[2 * t + 1] = i1; tokg[2 * t] = g0; tokg[2 * t + 1] = g1; tokp[2 * t] = r0; tokp[2 * t + 1] = r1; sst[t] = ss[u]; } } }
    }
    VM_WAIT(); __syncthreads();
    if (tid < NE) base[tid] = (int)__hip_atomic_fetch_add((unsigned*)(ws + WS_CTL) + CW_ECNT + dmyc + 64 * tid, (unsigned)cnt[tid], __ATOMIC_RELAXED, __HIP_MEMORY_SCOPE_AGENT);
    __syncthreads();
    { const int t = gw + lane * NGW; if (t < T) { tokp[2 * t] += base[toke[2 * t]]; tokp[2 * t + 1] += base[toke[2 * t + 1]]; } }
    __syncthreads();
}
struct MoeTiles { int ts[9]; };
__device__ __forceinline__ MoeTiles moe_tiles(const unsigned char* ws) {
    MoeTiles m; int acc = 0;
#pragma unroll
    for (int e = 0; e < NE; ++e) { m.ts[e] = acc; const unsigned c = (unsigned)__builtin_amdgcn_readfirstlane((int)__hip_atomic_load((const unsigned*)(ws + WS_CTL) + CW_ECNT + 64 * e, __ATOMIC_RELAXED, __HIP_MEMORY_SCOPE_AGENT)); acc += (int)((c + 255u) >> 8); }
    m.ts[8] = acc; return m;
}
__device__ __forceinline__ void gather_phase(unsigned char* ws, int gw, int NGW, int lane) {
    const MoeTiles mt = moe_tiles(ws);
    const int* toke = (const int*)(ws + WS_TOKE); int* tokp = (int*)(ws + WS_TOKP); const float* sst = (const float*)(ws + WS_SST); float* ssrow = (float*)(ws + WS_SSROW);
    const unsigned char* xb = ws + WS_XB8; unsigned char* hs = ws + WS_HS;
    constexpr int U = 4;
    for (int t0 = gw; t0 < T; t0 += U * NGW) {
        int p0[U], p1[U]; v4u a[U]; float s[U];
#pragma unroll
        for (int u = 0; u < U; ++u) { const int t = (t0 + u * NGW < T) ? t0 + u * NGW : t0; const int e0 = toke[2 * t], e1 = toke[2 * t + 1];
            int o0 = 0, o1 = 0;
#pragma unroll
            for (int e = 0; e < NE; ++e) { if (e == e0) o0 = mt.ts[e]; if (e == e1) o1 = mt.ts[e]; }
            p0[u] = o0 * 256 + tokp[2 * t]; p1[u] = o1 * 256 + tokp[2 * t + 1]; s[u] = sst[t];
            a[u] = __builtin_nontemporal_load((const GAS v4u*)(xb + (size_t)t * DM) + lane); }
#pragma unroll
        for (int u = 0; u < U; ++u) { const int t = t0 + u * NGW; if (t < T) {
            *((GAS v4u*)(hs + (size_t)p0[u] * DM) + lane) = a[u]; *((GAS v4u*)(hs + (size_t)p1[u] * DM) + lane) = a[u];
            if (lane == 0) { ssrow[p0[u]] = s[u]; ssrow[p1[u]] = s[u]; tokp[2 * t] = p0[u]; tokp[2 * t + 1] = p1[u]; } } }
    }
}
__device__ __forceinline__ void final_phase(float* xo, const bf16* xres, const float* fg, const unsigned char* ws, int gw, int NGW, int lane, float* dst = nullptr) {
    const int* tokp = (const int*)(ws + WS_TOKP); const float* tokg = (const float*)(ws + WS_TOKG); const unsigned char* y2 = ws + WS_Y2;
    constexpr int U = 4;
    for (int t0 = gw; t0 < T; t0 += U * NGW) {
        f32x4 xv[U][4]; unsigned ya[U][4], yb[U][4]; float g0[U], g1[U];
#pragma unroll
        for (int u = 0; u < U; ++u) { const int t = (t0 + u * NGW < T) ? t0 + u * NGW : t0; const int p0 = tokp[2 * t], p1 = tokp[2 * t + 1]; g0[u] = tokg[2 * t]; g1[u] = tokg[2 * t + 1];
            const GAS v2u* xr = (const GAS v2u*)(xres + (size_t)t * DM) + lane; const GAS unsigned* pa = (const GAS unsigned*)(y2 + (size_t)p0 * DM) + lane; const GAS unsigned* pb = (const GAS unsigned*)(y2 + (size_t)p1 * DM) + lane;
#pragma unroll
            for (int j = 0; j < 4; ++j) { const v2u w = xr[64 * j]; xv[u][j] = (f32x4){__uint_as_float(w.x << 16), __uint_as_float(w.x & 0xffff0000u), __uint_as_float(w.y << 16), __uint_as_float(w.y & 0xffff0000u)}; ya[u][j] = __builtin_nontemporal_load(pa + 64 * j); yb[u][j] = __builtin_nontemporal_load(pb + 64 * j); } }
#pragma unroll
        for (int u = 0; u < U; ++u) { const int t = t0 + u * NGW; if (t < T) {
            f32x4 v[4]; float ss = 0.f;
#pragma unroll
            for (int j = 0; j < 4; ++j) { typedef float f2_t __attribute__((ext_vector_type(2)));
                const f2_t a01 = __builtin_amdgcn_cvt_pk_f32_fp8((int)ya[u][j], false), a23 = __builtin_amdgcn_cvt_pk_f32_fp8((int)ya[u][j], true), c01 = __builtin_amdgcn_cvt_pk_f32_fp8((int)yb[u][j], false), c23 = __builtin_amdgcn_cvt_pk_f32_fp8((int)yb[u][j], true);
                const float h0 = g0[u] * (1.0f / pg8::Y_SCALE), h1 = g1[u] * (1.0f / pg8::Y_SCALE);
                v[j].x = xv[u][j].x + h0 * a01.x + h1 * c01.x; v[j].y = xv[u][j].y + h0 * a01.y + h1 * c01.y; v[j].z = xv[u][j].z + h0 * a23.x + h1 * c23.x; v[j].w = xv[u][j].w + h0 * a23.y + h1 * c23.y;
                ss += (v[j].x * v[j].x + v[j].y * v[j].y) + (v[j].z * v[j].z + v[j].w * v[j].w); }
            ss = wave_sum(ss); const float rs = 1.0f / sqrtf(ss * (1.0f / 1024.0f) + 1e-5f);
            GAS f32x4* orow = (GAS f32x4*)((dst ? dst : xo) + (size_t)t * DM) + lane;
#pragma unroll
            for (int j = 0; j < 4; ++j) { const f32x4 g = *(const f32x4*)(fg + 256 * j + 4 * lane); __builtin_nontemporal_store(v[j] * rs * g, orow + 64 * j); } } }
    }
}
__device__ __forceinline__ unsigned char* opq(unsigned char* p) { asm volatile("" : "+s"(p)); return p; }
struct Args { const float* in[22]; float* out; unsigned char* ws; int ph_lo, ph_hi; };
#ifndef PHASE_MASK
#define PHASE_MASK 0xFFFFFFFFull
#endif
#ifndef MIX_MASK
#define MIX_MASK 7
#endif
__global__ void __launch_bounds__(NWAVES * 64, 2) hymba_fwd(Args args) {
    extern __shared__ __attribute__((aligned(16))) unsigned char lds_raw[];
    LAS unsigned char* lds = (LAS unsigned char*)lds_raw;
    volatile LAS unsigned* MISC = (volatile LAS unsigned*)(lds + MISC_OFF);
    for (int u = threadIdx.x; u < (LDS_BYTES - LDSCTL_OFF) / 4; u += NWAVES * 64) ((LAS unsigned*)(lds + LDSCTL_OFF))[u] = 0u;
    __syncthreads();
    if (threadIdx.x == 0) {
#pragma unroll
        for (int i = 0; i < 22; ++i) ((LAS unsigned long long*)(lds + LDSCTL_OFF))[i] = (unsigned long long)args.in[i];
        ((LAS unsigned long long*)(lds + LDSCTL_OFF))[22] = (unsigned long long)args.out; ((LAS unsigned long long*)(lds + LDSCTL_OFF))[23] = (unsigned long long)args.ws;
    }
    __syncthreads();
    XcdBarrier bar; bar.bar = nullptr; bar.x = 0; bar.st = MISC + 8;
    if (!MK_PER_PHASE) bar = xcd_barrier_post((unsigned*)((unsigned char*)inp(lds, 23) + WS_CTL) + CW_BAR, MISC + 8);
    MISC[10] = bar.x;
#ifdef PROBE_PT
    if (threadIdx.x == 0) *(volatile LAS unsigned long long*)(MISC + 16) = __builtin_amdgcn_s_memrealtime();
#endif
#if MK_PER_PHASE
    MISC[11] = (unsigned)args.ph_lo; MISC[12] = (unsigned)args.ph_hi;
#define IN(k) (((PHASE_MASK >> (k)) & 1ull) && (int)MISC[11] <= (k) && (k) < (int)MISC[12])
#define SEAM(k) do { } while (0)
#else
#define IN(k) ((PHASE_MASK >> (k)) & 1ull)
#ifdef PROBE_WAIT
#define SEAM_T0(k) unsigned long long t0_ = 0; if (((PROBE_WAIT) >> (k)) & 1ull) t0_ = __builtin_amdgcn_s_memrealtime();
#define SEAM_T1(k) if ((((PROBE_WAIT) >> (k)) & 1ull) && threadIdx.x == 0) MISC[13] = MISC[13] + (unsigned)(__builtin_amdgcn_s_memrealtime() - t0_);
#elif defined(PROBE_PT)
#define SEAM_T0(k) if (((PROBE_PT) >> (k)) & 1ull) __syncthreads(); if ((((PROBE_PT) >> (k)) & 1ull) && threadIdx.x == 0) { const unsigned long long nw_ = __builtin_amdgcn_s_memrealtime(), st_ = *(volatile LAS unsigned long long*)(MISC + 16), dl_ = (unsigned long long)(PROBE_K) * (nw_ - st_); \
        while (__builtin_amdgcn_s_memrealtime() - nw_ < dl_) __builtin_amdgcn_s_sleep(8); }
#define SEAM_T1(k) if (threadIdx.x == 0) *(volatile LAS unsigned long long*)(MISC + 16) = __builtin_amdgcn_s_memrealtime();
#else
#define SEAM_T0(k)
#define SEAM_T1(k)
#endif
#define SEAM(k) do { SEAM_T0(k) for (int sr_ = 0; sr_ < DUPN(45); ++sr_) { XcdBarrier b2_; b2_.bar = (unsigned*)((unsigned char*)inp(lds, 23) + WS_CTL) + CW_BAR; b2_.x = __builtin_amdgcn_readfirstlane(MISC[10]); b2_.st = MISC + 8; xcd_barrier(b2_); } SEAM_T1(k) } while (0)
#endif
#define PHASE_CTX \
    int tid = threadIdx.x; asm volatile("" : "+v"(tid)); const int lane = tid & 63, wave = __builtin_amdgcn_readfirstlane(tid >> 6); \
    int G = gridDim.x, bx = blockIdx.x; asm volatile("" : "+s"(G), "+s"(bx)); const int vcu = (G % 8 == 0) ? (bx % 8) * (G / 8) + bx / 8 : bx; \
    const int gw = vcu * NWAVES + wave, NGW = G * NWAVES; \
    unsigned char* const ws = (unsigned char*)inp(lds, 23); float* const xo = (float*)inp(lds, 22); \
    bf16* XB = (bf16*)(ws + WS_XB); bf16* UB = (bf16*)(ws + WS_UB); bf16* QD = (bf16*)(ws + WS_QD); bf16* Y = (bf16*)(ws + WS_Y); bf16* OC = (bf16*)(ws + WS_OC); float* LSE = (float*)(ws + WS_LSE); \
    (void)lane; (void)wave; (void)vcu; (void)gw; (void)NGW; (void)xo; (void)XB; (void)UB; (void)QD; (void)Y; (void)OC; (void)LSE;

    if (IN(0)) for (int rep_ = 0; rep_ < DUPN(0); ++rep_) { PHASE_CTX p0_prologue(ws, lds, vcu, G, tid, lane, wave); }
    SEAM(0);

#define LAYER_COMMON(l, pb) \
    if (IN(pb)) for (int rep_ = 0; rep_ < DUPN(pb); ++rep_) { PHASE_CTX \
        pg8::Gemm g{XB, (const bf16*)(ws + WS_WIN + (l) * SZ_WIN), T, NIN, DM}; pg8::StaticOrder S; S.init(T, NIN, G, bx); \
        pg8::EpiIn<(l) != 0> E{(const float*)(ws + ((l) == 0 ? WS_SS0 : WS_SSP)), UB, QD, (const float*)(ws + WS_ROPEC), (const float*)(ws + WS_ROPED), (size_t)T * 256}; \
        if ((l) == 0 && (bx & 1)) { tr_loop(ws, lds, TR_N0, TR_NALL - TR_N0, gw, NGW, (LAS float*)(lds + RING_OFF + wave * 16384), lane); __syncthreads(); }     \
        pg8::gemm_phase<pg8::EpiIn<(l) != 0>, pg8::StaticOrder, true, true>(lds + RING_OFF, g, S, E); \
        if ((l) == 0 && !(bx & 1)) { tr_loop(ws, lds, TR_N0, TR_NALL - TR_N0, gw, NGW, (LAS float*)(lds + RING_OFF + wave * 16384), lane); } \
    } \
    SEAM(pb); \
    if (IN((pb) + 1)) { \
        if (MIX_MASK & 1) for (int rep_ = DUPN(40) - 1; rep_ >= 0; --rep_) { PHASE_CTX \
          const bf16* KD = UB + (size_t)5 * T * 256; const bf16* VD = UB + (size_t)6 * T * 256; \
          const float* mi_ = (const float*)(ws + WS_MISC); const float lam_ = mi_[2 * (l)], omli_ = mi_[2 * (l) + 1]; const float* dg_ = IN_(11) + (l) * 64; \
          for (int i = 0; ; ++i) {                                    \
            int pair, qb; \
            if (G == 256) { if (i >= 2) break; const int s = vcu & 7; pair = vcu >> 3; qb = (i == 0) ? s : 15 - s; } \
            else { const int id = i * G + vcu; if (id >= 512) break; pair = id >> 4; qb = id & 15; } \
            attn_body::attn_unit<8, 1>(pair >> 2, 2 * (pair & 3), qb, (const attn_body::bf16*)QD, (const attn_body::bf16*)KD, (const attn_body::bf16*)VD, nullptr, (char*)lds_raw + RING_OFF); \
            attn_body::attn_unit<8, 2>(pair >> 2, 2 * (pair & 3) + 1, qb, (const attn_body::bf16*)QD, (const attn_body::bf16*)KD, (const attn_body::bf16*)VD, (attn_body::bf16*)(Y + 768), (char*)lds_raw + RING_OFF, lam_, omli_, dg_); \
          } \
          __syncthreads(); } \
        if (MIX_MASK & 2) for (int rep_ = 0; rep_ < DUPN(41); ++rep_) { PHASE_CTX v4u kr_[6], vr_[6]; const bf16* QC_ = UB + (size_t)2 * T * 256; const bf16* KC_ = UB + (size_t)3 * T * 256; const bf16* VC_ = UB + (size_t)4 * T * 256; \
          if (vcu < 1536) dil_load(vcu, KC_, VC_, tid, kr_, vr_); \
          for (int uc = vcu; uc < 1536; uc += G) { bf16x8 qr_[4]; dil_loadq(uc, QC_, lane, wave, qr_); dil_stage(uc, kr_, vr_, lds + RING_OFF, tid); __syncthreads(); dil_compute(uc, qr_, OC, LSE, lds + RING_OFF, lane, wave, (uc + G < 1536) ? uc + G : -1, KC_, VC_, tid, kr_, vr_); } } \
        if (MIX_MASK & 4) for (int rep_ = 0; rep_ < DUPN(42); ++rep_) { PHASE_CTX for (int un = vcu; un < 512; un += G) ab_unit(un, IN_(3) + (l) * CONVW * GW, IN_(4) + (l) * GW, IN_(5) + (l) * GW, IN_(6) + (l) * GW, UB, UB + (size_t)T * 256, Y, lds + RING_OFF, tid, lane, wave); } \
    } \
    SEAM((pb) + 1); \
    if (IN((pb) + 2)) for (int rep_ = 0; rep_ < DUPN((pb) + 2); ++rep_) { PHASE_CTX const float* mi = (const float*)(ws + WS_MISC); comb_phase(OC, LSE, QD, Y, IN_(11) + (l) * 64, mi[2 * (l)], mi[2 * (l) + 1], gw, NGW, lane); } \
    SEAM((pb) + 2); \
    if (IN((pb) + 3)) for (int rep_ = 0; rep_ < ((l) == 0 ? DUPN(4) : 1); ++rep_) { PHASE_CTX \
        pg8::Gemm g{Y, (const bf16*)(ws + WS_WOUT + (l) * SZ_WOUT), T, DM, DM}; pg8::StaticOrder S; S.init(T, DM, G, bx); \
        pg8::EpiRes<(l) == 0, (l) != 0, (l) == 0> E{IN_(0), XB, ws + WS_XB8, (float*)(ws + WS_SSP), 1.0f}; pg8::gemm_phase<pg8::EpiRes<(l) == 0, (l) != 0, (l) == 0>, pg8::StaticOrder, true, true>(lds + RING_OFF, g, S, E); \
    } \
    SEAM((pb) + 3);

    LAYER_COMMON(0, 1)
    if (IN(5)) for (int rep_ = 0; rep_ < DUPN(5); ++rep_) { PHASE_CTX
        pg8::Gemm g{XB, (const bf16*)(ws + WS_W1), T, 2 * DFF, DM}; pg8::StaticOrder S; S.init(T, 2 * DFF, G, bx);
        pg8::EpiGlu<true, false> E{ws + WS_HID, DFF, (const float*)(ws + WS_SSP), 0};
        pg8::gemm_phase<pg8::EpiGlu<true, false>, pg8::StaticOrder, true, true>(lds + RING_OFF, g, S, E);
    }
    SEAM(5);
    if (IN(6)) { PHASE_CTX
        pg8::Gemm g{(const bf16*)(ws + WS_HID), (const bf16*)(ws + WS_W2), T, DM, DFF}; pg8::StaticOrder S; S.init(T, DM, G, bx);
        pg8::EpiRes<true, false, false> E{nullptr, XB, nullptr, (float*)(ws + WS_SSP), 1.0f};
        pg8::gemm_phase<pg8::EpiRes<true, false, false>, pg8::StaticOrder, true, true>(lds + RING_OFF, g, S, E);
    }
    SEAM(6);
    LAYER_COMMON(1, 7)
#undef LAYER_COMMON
    if (IN(11) && DUPN(43) > 1) { PHASE_CTX route_phase(XB, IN_(13) + DM, IN_(17), ws, lds + RING_OFF, vcu, G, tid, lane, wave, WS_HIDE - WS_TOKE, 1024); }
    if (IN(11)) { PHASE_CTX route_phase(XB, IN_(13) + DM, IN_(17), ws, lds + RING_OFF, vcu, G, tid, lane, wave); }
    SEAM(11);
    if (IN(12)) for (int rep_ = 0; rep_ < DUPN(12); ++rep_) { PHASE_CTX gather_phase(ws, gw, NGW, lane); }
    SEAM(12);
#define MOE_SETUP(kk) const MoeTiles mt = moe_tiles(ws); const int nt_ = mt.ts[8], nfull_ = nt_ / MOE_CHUNK_TILES, rem_ = nt_ - nfull_ * MOE_CHUNK_TILES; \
        const int t0_ = (kk) == 0 ? 0 : rem_ + MOE_CHUNK_TILES * ((kk) - 1); int nm_ = (kk) == 0 ? rem_ : ((kk) <= nfull_ ? MOE_CHUNK_TILES : 0);
#define MOE_TS(S) S.ts1 = mt.ts[1]; S.ts2 = mt.ts[2]; S.ts3 = mt.ts[3]; S.ts4 = mt.ts[4]; S.ts5 = mt.ts[5]; S.ts6 = mt.ts[6]; S.ts7 = mt.ts[7];
#define MOE_PHASE(k) \
    if (IN(13 + (k))) { \
        int lev_r_ = 0; \
        if ((k) >= 1) for (int rep_ = 0; rep_ < DUPN(13 + (k)); ++rep_) { PHASE_CTX MOE_SETUP((k) - 1) \
            pg8::Gemm g{(const bf16*)(ws + WS_HIDE + (((k) - 1) & 1) * SZ_HIDE), (const bf16*)(ws + WS_W2E), nm_ * 256, DM, DFE / 2}; \
            pg8::MoeOrder S; S.init(nm_ * 256, DM, G, bx); S.tile0 = t0_; S.a_off = t0_; MOE_TS(S) S.estride = SZ_W2E; S.lev_r = 0; S.lev_d = 0; lev_r_ = (nm_ * 4) % G; \
            pg8::EpiY E{ws + WS_Y2}; \
            pg8::gemm_phase<pg8::EpiY, pg8::MoeOrder, true, true, true>(lds + RING_OFF, g, S, E); } \
        if ((k) <= 4) { PHASE_CTX MOE_SETUP(k) \
            pg8::Gemm g{(const bf16*)(ws + WS_HS), (const bf16*)(ws + WS_W1E), nm_ * 256, 2 * DFE, DM / 2}; \
            pg8::MoeOrder S; S.init(nm_ * 256, 2 * DFE, G, bx); S.tile0 = t0_; S.a_off = 0; MOE_TS(S) S.estride = SZ_W1E; S.lev_r = lev_r_; S.lev_d = (lev_r_ > 0 && (long)(G - lev_r_) * 3 <= (long)nm_ * 28) ? 3 : 0; \
            pg8::EpiGlu<false, true> E{ws + WS_HIDE + ((k) & 1) * SZ_HIDE, DFE, (const float*)(ws + WS_SSROW), t0_}; \
            pg8::gemm_phase<pg8::EpiGlu<false, true>, pg8::MoeOrder, true, true, true>(lds + RING_OFF, g, S, E); } \
    } \
    SEAM(13 + (k));
    MOE_PHASE(0) MOE_PHASE(1) MOE_PHASE(2) MOE_PHASE(3) MOE_PHASE(4) MOE_PHASE(5)
#undef MOE_PHASE
#undef MOE_SETUP
#undef MOE_TS
    if (IN(N_PHASES - 1) && DUPN(44) > 1) { PHASE_CTX final_phase(xo, XB, IN_(21), ws, gw, NGW, lane, (float*)(ws + WS_HIDE)); }
    if (IN(N_PHASES - 1)) { PHASE_CTX final_phase(xo, XB, IN_(21), ws, gw, NGW, lane); }
#ifdef PROBE_PT
    { __syncthreads(); SEAM_T0(N_PHASES - 1) __syncthreads(); }
#endif
#ifdef PROBE_WAIT
    {
        __syncthreads();
        unsigned* pw_ = (unsigned*)((unsigned char*)inp(lds, 23) + WS_CTL) + 12288;
        if (threadIdx.x == 0) atomicAdd(pw_, MISC[13]);
        SEAM(63);
        if (threadIdx.x == 0) { const unsigned sum_ = __hip_atomic_load(pw_, __ATOMIC_RELAXED, __HIP_MEMORY_SCOPE_AGENT); const unsigned long long dl_ = (unsigned long long)(PROBE_K) * (sum_ / gridDim.x);
            const unsigned long long ts_ = __builtin_amdgcn_s_memrealtime(); while (__builtin_amdgcn_s_memrealtime() - ts_ < dl_) __builtin_amdgcn_s_sleep(8); }
        __syncthreads();
    }
#endif
#undef IN
#undef SEAM
#undef PHASE_CTX
}

extern "C" void kernel_launch(void* const* d_in, const int* in_sizes, int n_in, void* d_out, int out_size, void* d_ws, size_t ws_size, hipStream_t stream) {
    static int grid = 0;
    if (grid == 0) {
        if (n_in != 22 || in_sizes[0] != T * DM || out_size != T * DM || ws_size < WS_END) { fprintf(stderr, "kernel_launch: unexpected shapes (n_in %d, ws %zu, need %zu); nothing launched\n", n_in, ws_size, (size_t)WS_END); grid = -1; return; }
        int dev = 0, cus = 0;
        if (hipGetDevice(&dev) != hipSuccess || hipDeviceGetAttribute(&cus, hipDeviceAttributeMultiprocessorCount, dev) != hipSuccess) { grid = -1; return; }
        if (hipFuncSetAttribute((const void*)hymba_fwd, hipFuncAttributeMaxDynamicSharedMemorySize, LDS_BYTES) != hipSuccess) { fprintf(stderr, "kernel_launch: hipFuncSetAttribute failed\n"); grid = -1; return; }
        int per_cu = 0;
        if (hipOccupancyMaxActiveBlocksPerMultiprocessor(&per_cu, (const void*)hymba_fwd, NWAVES * 64, LDS_BYTES) != hipSuccess || per_cu < 1) fprintf(stderr, "kernel_launch: note: occupancy query reports %d\n", per_cu);
        (void)hipGetLastError();
        grid = cus;
    }
    if (grid < 0) return;
    if (hipMemsetAsync((char*)d_ws + WS_CTL, 0, CTL_ZERO_BYTES, stream) != hipSuccess) return;
    Args a{};
    for (int i = 0; i < 22; ++i) a.in[i] = (const float*)d_in[i];
    a.out = (float*)d_out; a.ws = (unsigned char*)d_ws;
#if MK_PER_PHASE
    for (int p = 0; p < N_PHASES; ++p) { a.ph_lo = p; a.ph_hi = p + 1; hipLaunchKernelGGL(hymba_fwd, dim3(grid), dim3(NWAVES * 64), LDS_BYTES, stream, a); }
#else
    a.ph_lo = 0; a.ph_hi = N_PHASES;
    hipLaunchKernelGGL(hymba_fwd, dim3(grid), dim3(NWAVES * 64), LDS_BYTES, stream, a);
#endif
}
```
